# Optimizing an MI355X kernel written in HIP

```python
import math
import jax, jax.numpy as jnp
from jax import lax
import numpy as np

D_MODEL = 1024
BATCH = 16
SEQ = 2048
DEPTH = 4

N_MLA_HEADS = 4
MLA_NOPE_DIM = 64
MLA_ROPE_DIM = 32
MLA_QK_DIM = MLA_NOPE_DIM + MLA_ROPE_DIM
MLA_V_DIM = 64
MLA_Q_RANK = 384
MLA_KV_RANK = 256
MLA_WIDTH = N_MLA_HEADS * MLA_V_DIM
N_FOX_HEADS = 4
FOX_HEAD_DIM = 64
FOX_WIDTH = N_FOX_HEADS * FOX_HEAD_DIM
FOX_FORGET_BIAS_INIT = 3.0
S5_GROUPS = 16
S5_GROUP_CH = 16
S5_STATE = 64
S5_WIDTH = S5_GROUPS * S5_GROUP_CH
N_BRANCHES = 3
BRANCH_WIDTH = 256
D_FF = 2816
CONV_WIDTH = 3
Q_BLOCK = 128
ROPE_THETA = 10000.0
NORM_EPS = 1e-6
NEG_INF = -1e30
IN_WIDTHS = (MLA_Q_RANK, MLA_KV_RANK, MLA_ROPE_DIM,
             FOX_WIDTH, FOX_WIDTH, FOX_WIDTH, N_FOX_HEADS,
             S5_WIDTH, N_BRANCHES * D_MODEL)
D_IN = sum(IN_WIDTHS)

kernel_name = "hybrid_mla_fox_s5_gated_trunk"


def rms_norm(x, gain):
    x32 = x.astype(jnp.float32)
    y = x32 * lax.rsqrt(jnp.mean(x32 * x32, axis=-1, keepdims=True) + NORM_EPS)
    return (y * gain.astype(jnp.float32)).astype(x.dtype)


def rope_tables(positions):
    inv_freq = ROPE_THETA ** (-jnp.arange(0, MLA_ROPE_DIM, 2, dtype=jnp.float32) / MLA_ROPE_DIM)
    ang = positions.astype(jnp.float32)[..., None] * inv_freq
    return jnp.cos(ang)[:, :, None, :], jnp.sin(ang)[:, :, None, :]


def apply_rope_tail(x, cos, sin):
    x_pass, x_rot = x[..., :MLA_NOPE_DIM], x[..., MLA_NOPE_DIM:]
    x1, x2 = jnp.split(x_rot, 2, axis=-1)
    rot = jnp.concatenate([x1 * cos - x2 * sin, x2 * cos + x1 * sin], axis=-1)
    return jnp.concatenate([x_pass, rot.astype(x.dtype)], axis=-1)


def causal_block_attention(q, k, v, log_forget_cum=None):
    seq = q.shape[1]
    scale = q.shape[-1] ** -0.5
    outs = []
    for i in range(seq // Q_BLOCK):
        q_lo, q_hi = i * Q_BLOCK, (i + 1) * Q_BLOCK
        qb, kb, vb = q[:, q_lo:q_hi], k[:, :q_hi], v[:, :q_hi]
        s = jnp.einsum('bqhd,bkhd->bhqk', qb, kb).astype(jnp.float32) * scale
        if log_forget_cum is not None:
            c_q = jnp.transpose(log_forget_cum[:, q_lo:q_hi], (0, 2, 1))[..., :, None]
            c_k = jnp.transpose(log_forget_cum[:, :q_hi], (0, 2, 1))[..., None, :]
            s = s + (c_q - c_k)
        mask = (q_lo + jnp.arange(Q_BLOCK))[:, None] >= jnp.arange(q_hi)[None, :]
        p = jax.nn.softmax(jnp.where(mask, s, NEG_INF), axis=-1).astype(v.dtype)
        outs.append(jnp.einsum('bhqk,bkhd->bqhd', p, vb))
    return jnp.concatenate(outs, axis=1)


def s5_branch(u, lam_re, lam_im, b_re, b_im, c_re, c_im, d, log_step, w_glu, b_glu):
    bsz, seq, _ = u.shape
    u32 = u.astype(jnp.float32).reshape(bsz, seq, S5_GROUPS, S5_GROUP_CH)
    lam = lax.complex(lam_re.astype(jnp.float32), lam_im.astype(jnp.float32))
    step = jnp.exp(log_step.astype(jnp.float32))[:, None]
    lam_bar = jnp.exp(lam * step)
    b_mat = lax.complex(b_re.astype(jnp.float32), b_im.astype(jnp.float32))
    b_bar = ((lam_bar - 1.0) / lam)[..., None] * b_mat
    bu = jnp.einsum('gph,bsgh->bsgp', b_bar, u32.astype(jnp.complex64))
    a = jnp.broadcast_to(lam_bar, bu.shape)

    def combine(e1, e2):
        a1, x1 = e1
        a2, x2 = e2
        return a1 * a2, a2 * x1 + x2

    _, state = lax.associative_scan(combine, (a, bu), axis=1)
    c_mat = lax.complex(c_re.astype(jnp.float32), c_im.astype(jnp.float32))
    y = jnp.real(jnp.einsum('ghp,bsgp->bsgh', c_mat, state)) + d.astype(jnp.float32) * u32
    y = jax.nn.gelu(y.reshape(bsz, seq, S5_WIDTH))
    y = y * jax.nn.sigmoid(y @ w_glu.astype(jnp.float32) + b_glu.astype(jnp.float32))
    return y.astype(u.dtype)


def causal_depthwise_conv(h, w):
    seq = h.shape[1]
    hp = jnp.pad(h, ((0, 0), (CONV_WIDTH - 1, 0), (0, 0)))
    return sum(w[j] * hp[:, j:j + seq] for j in range(CONV_WIDTH))


def mixer_block(h, cos, sin, w_in, q_lat_norm_g, w_uq, kv_lat_norm_g, w_ukv,
                mla_q_norm_g, mla_k_norm_g, fox_q_norm_g, fox_k_norm_g, fox_f_bias,
                s5_lambda_re, s5_lambda_im, s5_b_re, s5_b_im, s5_c_re, s5_c_im, s5_d,
                s5_log_step, s5_w_glu, s5_b_glu, w_branch, w_out):
    bsz, seq, _ = h.shape
    proj = h @ w_in
    split_points = np.cumsum(IN_WIDTHS)[:-1].tolist()
    c_q, c_kv, k_r, fq, fk, fv, f_logit, u, gate_logits = jnp.split(proj, split_points, axis=-1)

    q = jnp.einsum('bsr,rhd->bshd', rms_norm(c_q, q_lat_norm_g), w_uq)
    kv = jnp.einsum('bsr,rhd->bshd', rms_norm(c_kv, kv_lat_norm_g), w_ukv)
    k_nope, v_mla = kv[..., :MLA_NOPE_DIM], kv[..., MLA_NOPE_DIM:]
    k_rope = jnp.broadcast_to(k_r[:, :, None, :], (bsz, seq, N_MLA_HEADS, MLA_ROPE_DIM))
    k_mla = jnp.concatenate([k_nope, k_rope], axis=-1)
    q_mla = apply_rope_tail(rms_norm(q, mla_q_norm_g), cos, sin)
    k_mla = apply_rope_tail(rms_norm(k_mla, mla_k_norm_g), cos, sin)
    o_mla = causal_block_attention(q_mla, k_mla, v_mla).reshape(bsz, seq, MLA_WIDTH)

    q_fox = rms_norm(fq.reshape(bsz, seq, N_FOX_HEADS, FOX_HEAD_DIM), fox_q_norm_g)
    k_fox = rms_norm(fk.reshape(bsz, seq, N_FOX_HEADS, FOX_HEAD_DIM), fox_k_norm_g)
    v_fox = fv.reshape(bsz, seq, N_FOX_HEADS, FOX_HEAD_DIM)
    log_f = jax.nn.log_sigmoid((f_logit + fox_f_bias).astype(jnp.float32))
    cum_log_f = lax.cumsum(log_f, axis=1)
    o_fox = causal_block_attention(q_fox, k_fox, v_fox, cum_log_f).reshape(bsz, seq, FOX_WIDTH)

    o_s5 = s5_branch(u, s5_lambda_re, s5_lambda_im, s5_b_re, s5_b_im, s5_c_re, s5_c_im,
                     s5_d, s5_log_step, s5_w_glu, s5_b_glu)

    branches = jnp.stack([o_mla, o_fox, o_s5], axis=2)
    gates = jax.nn.sigmoid(gate_logits.reshape(bsz, seq, N_BRANCHES, D_MODEL))
    projected = jnp.einsum('bsnw,nwd->bsnd', branches, w_branch)
    merged = jnp.einsum('bsnd,bsnd->bsd', gates, projected)
    return merged @ w_out


def conv_gated_ffn(h, w_up, conv_w, w_down):
    up = causal_depthwise_conv(h @ w_up, conv_w)
    gate, val = jnp.split(up, 2, axis=-1)
    return (jax.nn.silu(gate) * val) @ w_down


def setup_inputs(seed: int = 0) -> dict:
    key = jax.random.key(seed)
    ks = iter(jax.random.split(key, 40))
    f32 = jnp.float32
    L = DEPTH

    def nrm(shape, scale):
        return scale * jax.random.normal(next(ks), shape, f32)

    def gain(shape):
        return 1.0 + nrm(shape, 0.02)

    x = nrm((BATCH, SEQ, D_MODEL), 1.0)
    offset = jax.random.randint(next(ks), (BATCH, 1), 0, 4096, dtype=jnp.int32)
    positions = offset + jnp.arange(SEQ, dtype=jnp.int32)[None, :]

    attn_norm_g = gain((L, D_MODEL))
    w_in = nrm((L, D_MODEL, D_IN), D_MODEL ** -0.5)
    q_lat_norm_g = gain((L, MLA_Q_RANK))
    w_uq = nrm((L, MLA_Q_RANK, N_MLA_HEADS, MLA_QK_DIM), MLA_Q_RANK ** -0.5)
    kv_lat_norm_g = gain((L, MLA_KV_RANK))
    w_ukv = nrm((L, MLA_KV_RANK, N_MLA_HEADS, MLA_NOPE_DIM + MLA_V_DIM), MLA_KV_RANK ** -0.5)
    mla_q_norm_g = gain((L, MLA_QK_DIM))
    mla_k_norm_g = gain((L, MLA_QK_DIM))
    fox_q_norm_g = gain((L, FOX_HEAD_DIM))
    fox_k_norm_g = gain((L, FOX_HEAD_DIM))
    fox_f_bias = FOX_FORGET_BIAS_INIT + nrm((L, N_FOX_HEADS), 0.5)
    s5_lambda_re = -0.5 + nrm((L, S5_GROUPS, S5_STATE), 0.01)
    s5_lambda_im = math.pi * jnp.arange(S5_STATE, dtype=f32) + nrm((L, S5_GROUPS, S5_STATE), 0.01)
    s5_b_re = nrm((L, S5_GROUPS, S5_STATE, S5_GROUP_CH), (2 * S5_GROUP_CH) ** -0.5)
    s5_b_im = nrm((L, S5_GROUPS, S5_STATE, S5_GROUP_CH), (2 * S5_GROUP_CH) ** -0.5)
    s5_c_re = nrm((L, S5_GROUPS, S5_GROUP_CH, S5_STATE), (2 * S5_STATE) ** -0.5)
    s5_c_im = nrm((L, S5_GROUPS, S5_GROUP_CH, S5_STATE), (2 * S5_STATE) ** -0.5)
    s5_d = nrm((L, S5_GROUPS, S5_GROUP_CH), 0.5)
    s5_log_step = jnp.log(jax.random.uniform(next(ks), (L, S5_GROUPS), f32, minval=0.001, maxval=0.1))
    s5_w_glu = nrm((L, S5_WIDTH, S5_WIDTH), S5_WIDTH ** -0.5)
    s5_b_glu = nrm((L, S5_WIDTH), 0.02)
    w_branch = nrm((L, N_BRANCHES, BRANCH_WIDTH, D_MODEL), BRANCH_WIDTH ** -0.5)
    w_out = nrm((L, D_MODEL, D_MODEL), D_MODEL ** -0.5)
    ffn_norm_g = gain((L, D_MODEL))
    w_up = nrm((L, D_MODEL, 2 * D_FF), D_MODEL ** -0.5)
    ffn_conv_w = nrm((L, CONV_WIDTH, 2 * D_FF), 0.2).at[:, CONV_WIDTH - 1].add(1.0)
    w_down = nrm((L, D_FF, D_MODEL), D_FF ** -0.5)
    return {"x": x, "positions": positions, "attn_norm_g": attn_norm_g, "w_in": w_in,
            "q_lat_norm_g": q_lat_norm_g, "w_uq": w_uq, "kv_lat_norm_g": kv_lat_norm_g,
            "w_ukv": w_ukv, "mla_q_norm_g": mla_q_norm_g, "mla_k_norm_g": mla_k_norm_g,
            "fox_q_norm_g": fox_q_norm_g, "fox_k_norm_g": fox_k_norm_g, "fox_f_bias": fox_f_bias,
            "s5_lambda_re": s5_lambda_re, "s5_lambda_im": s5_lambda_im, "s5_b_re": s5_b_re,
            "s5_b_im": s5_b_im, "s5_c_re": s5_c_re, "s5_c_im": s5_c_im, "s5_d": s5_d,
            "s5_log_step": s5_log_step, "s5_w_glu": s5_w_glu, "s5_b_glu": s5_b_glu,
            "w_branch": w_branch, "w_out": w_out, "ffn_norm_g": ffn_norm_g, "w_up": w_up,
            "ffn_conv_w": ffn_conv_w, "w_down": w_down}


def reference(x, positions, attn_norm_g, w_in, q_lat_norm_g, w_uq, kv_lat_norm_g, w_ukv,
              mla_q_norm_g, mla_k_norm_g, fox_q_norm_g, fox_k_norm_g, fox_f_bias,
              s5_lambda_re, s5_lambda_im, s5_b_re, s5_b_im, s5_c_re, s5_c_im, s5_d,
              s5_log_step, s5_w_glu, s5_b_glu, w_branch, w_out, ffn_norm_g, w_up,
              ffn_conv_w, w_down):
    cos, sin = rope_tables(positions)
    for l in range(DEPTH):
        h = rms_norm(x, attn_norm_g[l])
        x = x + mixer_block(h, cos, sin, w_in[l], q_lat_norm_g[l], w_uq[l], kv_lat_norm_g[l],
                            w_ukv[l], mla_q_norm_g[l], mla_k_norm_g[l], fox_q_norm_g[l],
                            fox_k_norm_g[l], fox_f_bias[l], s5_lambda_re[l], s5_lambda_im[l],
                            s5_b_re[l], s5_b_im[l], s5_c_re[l], s5_c_im[l], s5_d[l],
                            s5_log_step[l], s5_w_glu[l], s5_b_glu[l], w_branch[l], w_out[l])
        h = rms_norm(x, ffn_norm_g[l])
        x = x + conv_gated_ffn(h, w_up[l], ffn_conv_w[l], w_down[l])
    return x
```

```cpp
#include <hip/hip_runtime.h>
#include <hip/hip_cooperative_groups.h>
#include <cstdio>
#include <cstdint>
namespace cg = cooperative_groups;

#ifndef MK_MULTI
#define MK_MULTI 0
#endif

#ifndef PROBE_K
#define PROBE_K -1
#endif
#ifndef PROBE_KREP
#define PROBE_KREP -1
#endif
#ifndef PHSEL
#define PHSEL -1
#endif
#define PHON(x) (PHSEL < 0 || PHSEL == (x))
#define LAS __attribute__((address_space(3)))
typedef unsigned short bf16_t;
typedef short bf16x8 __attribute__((ext_vector_type(8)));
typedef float f32x2 __attribute__((ext_vector_type(2)));
typedef float f32x4 __attribute__((ext_vector_type(4)));
typedef float f32x16 __attribute__((ext_vector_type(16)));
typedef unsigned u32x2 __attribute__((ext_vector_type(2)));
typedef unsigned u32x4 __attribute__((ext_vector_type(4)));
typedef __bf16 bf16x2_t __attribute__((ext_vector_type(2)));
typedef short v4i16_t __attribute__((ext_vector_type(4)));

constexpr int NB = 16, SEQ = 2048, MTOK = NB * SEQ, DM = 1024, DFF = 2816, DIN = 4772, NLAYER = 4;
constexpr float EPS = 1e-6f, LOG2E = 1.4426950408889634f;
constexpr int NPHASE_PER_LAYER = 10, NPHASE = NLAYER * NPHASE_PER_LAYER;
constexpr int LDS_BYTES = 147456;
constexpr int LDS_XOFF = 131072;

constexpr size_t MiB = 1024 * 1024;
constexpr size_t WS_W = 1 * MiB;
constexpr size_t WO_IN1 = 0, WO_IN2 = WO_IN1 + 1792ull * 1024 * 2, WO_UQ = WO_IN2 + 3072ull * 1024 * 2, WO_UKV = WO_UQ + 512ull * 384 * 2,
                 WO_GLU = WO_UKV + 512ull * 256 * 2, WO_B = WO_GLU + 256ull * 256 * 2, WO_OUT = WO_B + 3ull * 1024 * 256 * 2,
                 WO_UP = WO_OUT + 1024ull * 1024 * 2, WO_DN = WO_UP + 5632ull * 1024 * 2, WO_END = WO_DN + 1024ull * 2816 * 2;
static_assert(WO_END <= 32 * MiB, "weights");
constexpr size_t WS_XB = WS_W + 32 * MiB + 1 * MiB;
constexpr size_t WS_SM = WS_XB + 64 * MiB + 1 * MiB;
constexpr size_t SM_SSQX = 0, SM_SSQCQ = SM_SSQX + (size_t)MTOK * 16 * 4, SM_SSQCKV = SM_SSQCQ + (size_t)MTOK * 8 * 4, SM_KRROT = SM_SSQCKV + (size_t)MTOK * 4 * 4,
                 SM_SSQKR = SM_KRROT + (size_t)MTOK * 32 * 4, SM_LOGF = SM_SSQKR + (size_t)MTOK * 4, SM_CL = SM_LOGF + (size_t)MTOK * 4 * 4, SM_SSQQN = SM_CL + (size_t)MTOK * 4 * 4,
                 SM_SSQQR = SM_SSQQN + (size_t)MTOK * 4 * 4, SM_COS = SM_SSQQR + (size_t)MTOK * 4 * 4, SM_SIN = SM_COS + (size_t)MTOK * 16 * 4, SM_END = SM_SIN + (size_t)MTOK * 16 * 4;
constexpr size_t WS_OBR = WS_SM + 16 * MiB;
static_assert(SM_END <= 16 * MiB, "small");
constexpr size_t WS_X = WS_OBR + 48 * MiB;
constexpr size_t XA_CQ = 0, XA_CKV = XA_CQ + (size_t)MTOK * 384 * 2, XA_U = XA_CKV + (size_t)MTOK * 256 * 2, XA_QF = XA_U + (size_t)MTOK * 256 * 2, XA_KF = XA_QF + (size_t)MTOK * 256 * 2,
                 XA_VF = XA_KF + (size_t)MTOK * 256 * 2, XA_Y2 = XA_VF + (size_t)MTOK * 256 * 2, XA_QM = XA_Y2 + (size_t)MTOK * 256 * 2, XA_KM = XA_QM + (size_t)MTOK * 384 * 2,
                 XA_VM = XA_KM + (size_t)MTOK * 384 * 2, XA_END = XA_VM + (size_t)MTOK * 256 * 2;
constexpr size_t XB_GATES = 0, XB_MERGED = XB_GATES + (size_t)MTOK * 3072 * 2, XB_END = XB_MERGED + (size_t)MTOK * 1024 * 2;
constexpr size_t XC_ACT = 0, XC_END = (size_t)MTOK * DFF * 2;
constexpr size_t X_BYTES = XB_END > XA_END ? (XB_END > XC_END ? XB_END : XC_END) : (XA_END > XC_END ? XA_END : XC_END);
constexpr size_t WS_END = WS_X + X_BYTES;

struct Params {
    const void* in[29];
    float* out;
    unsigned char* ws;
};

typedef __attribute__((address_space(1))) unsigned char g_u8;
__device__ __forceinline__ const void* launder_ptr(const void* p) { const g_u8* q = (const g_u8*)p; asm volatile("" : "+s"(q)); return (const void*)q; }
__device__ __forceinline__ unsigned char* launder_ws(unsigned char* p) { g_u8* q = (g_u8*)p; asm volatile("" : "+s"(q)); return (unsigned char*)q; }
#define PIN(i) launder_ptr(P.in[i])
__device__ __forceinline__ int tid_opaque() { int t = threadIdx.x; asm volatile("" : "+v"(t)); return t; }
__device__ __forceinline__ unsigned pk2(float lo, float hi) { f32x2 v = {lo, hi}; bf16x2_t b = __builtin_convertvector(v, bf16x2_t); return __builtin_bit_cast(unsigned, b); }
__device__ __forceinline__ float bf2f(unsigned short b) { return __uint_as_float(((unsigned)b) << 16); }
__device__ __forceinline__ unsigned short f2bf(float f) { return (unsigned short)(pk2(f, 0.f) & 0xffffu); }
__device__ __forceinline__ void store4(bf16_t* p, f32x4 v) { u32x2 w; w.x = pk2(v.x, v.y); w.y = pk2(v.z, v.w); *(u32x2*)p = w; }
__device__ __forceinline__ void store8(bf16_t* p, f32x4 a, f32x4 b) { u32x4 w; w.x = pk2(a.x, a.y); w.y = pk2(a.z, a.w); w.z = pk2(b.x, b.y); w.w = pk2(b.z, b.w); *(u32x4*)p = w; }
__device__ __forceinline__ f32x4 load4bf(const bf16_t* p) { u32x2 w = *(const u32x2*)p; f32x4 r; r.x = __uint_as_float(w.x << 16); r.y = __uint_as_float(w.x & 0xffff0000u); r.z = __uint_as_float(w.y << 16); r.w = __uint_as_float(w.y & 0xffff0000u); return r; }
__device__ __forceinline__ float sigmoidf_(float z) { return __builtin_amdgcn_rcpf(1.f + __builtin_amdgcn_exp2f(-z * LOG2E)); }
__device__ __forceinline__ float red_fq(float s) {
    const unsigned u = __float_as_uint(s);
    auto a = __builtin_amdgcn_permlane16_swap(u, u, false, false);
    const float t = __uint_as_float(a[0]) + __uint_as_float(a[1]);
    const unsigned v = __float_as_uint(t);
    auto b = __builtin_amdgcn_permlane32_swap(v, v, false, false);
    return __uint_as_float(b[0]) + __uint_as_float(b[1]);
}
__device__ __forceinline__ float dot4(f32x4 a) { return (a.x * a.x + a.y * a.y) + (a.z * a.z + a.w * a.w); }
template <int NP> __device__ __forceinline__ float row_total(const float* base, long row, int fq) {
    float s;
    if (NP == 16) { f32x4 v = *(const f32x4*)(base + row * 16 + 4 * fq); s = (v.x + v.y) + (v.z + v.w); }
    else if (NP == 8) { f32x2 v = *(const f32x2*)(base + row * 8 + 2 * fq); s = v.x + v.y; }
    else { s = base[row * 4 + fq]; }
    return red_fq(s);
}

template <int NP> __device__ __forceinline__ void row_scales(float (&rs)[2][4], const float* base, long row0, int fq, float inv_n) {
    float t[2][4];
#pragma unroll
    for (int ai = 0; ai < 2; ++ai)
#pragma unroll
        for (int m = 0; m < 4; ++m) { const long row = row0 + ai * 128 + m * 16;
            if (NP == 16) { const f32x4 v = *(const f32x4*)(base + row * 16 + 4 * fq); t[ai][m] = (v.x + v.y) + (v.z + v.w); }
            else if (NP == 8) { const f32x2 v = *(const f32x2*)(base + row * 8 + 2 * fq); t[ai][m] = v.x + v.y; }
            else t[ai][m] = base[row * 4 + fq]; }
#pragma unroll
    for (int ai = 0; ai < 2; ++ai)
#pragma unroll
        for (int m = 0; m < 4; ++m) rs[ai][m] = rsqrtf(red_fq(t[ai][m]) * inv_n + EPS);
}
__device__ __forceinline__ void sincos_acc(float x, float& s, float& c) {
    const double xd = (double)x;
    const double kd = __builtin_rint(xd * 0.63661977236758134308);
    const double rd = xd - kd * 1.57079632679489661923;
    const int q = ((int)kd) & 3;
    const float y = (float)rd, y2 = y * y;
    const float sy = y + y * y2 * (-1.6666666667e-1f + y2 * (8.3333333333e-3f + y2 * (-1.9841269841e-4f + y2 * 2.7557319224e-6f)));
    const float cy = 1.f + y2 * (-0.5f + y2 * (4.1666666667e-2f + y2 * (-1.3888888889e-3f + y2 * (2.4801587302e-5f + y2 * -2.7557319224e-7f))));
    s = (q == 0) ? sy : (q == 1) ? cy : (q == 2) ? -sy : -cy;
    c = (q == 0) ? cy : (q == 1) ? -sy : (q == 2) ? -cy : sy;
}
__device__ __forceinline__ float max3f(float a, float b, float c) { float r; asm("v_max3_f32 %0, %1, %2, %3" : "=v"(r) : "v"(a), "v"(b), "v"(c)); return r; }
__device__ __forceinline__ float min2f(float a, float b) { float r; asm("v_min_f32_e32 %0, %1, %2" : "=v"(r) : "v"(a), "v"(b)); return r; }
__device__ __forceinline__ float max2f(float a, float b) { float r; asm("v_max_f32_e32 %0, %1, %2" : "=v"(r) : "v"(a), "v"(b)); return r; }
__device__ __forceinline__ float dpp_ror1(float v) { return __builtin_bit_cast(float, __builtin_amdgcn_mov_dpp(__builtin_bit_cast(int, v), 0x121, 0xf, 0xf, true)); }
__device__ __forceinline__ float dpp_ror2(float v) { return __builtin_bit_cast(float, __builtin_amdgcn_mov_dpp(__builtin_bit_cast(int, v), 0x122, 0xf, 0xf, true)); }

namespace pg8 {
constexpr int BM = 256, BK = 64, HALF = 128, HTB = HALF * BK * 2, STAGE_BYTES = 8 * HTB, NXCD = 8, WGM = 8;
__device__ __forceinline__ int lds_byte(int r, int c) { const int st = (r >> 4) * 2 + (c >> 5), rr = r & 15, cc = c & 31, ob = rr * 64 + cc * 2; return st * 1024 + (ob ^ (((ob >> 9) & 1) << 5)); }
__device__ __forceinline__ void stage_rc(int b, int& R, int& C) { const int st = b / 1024, sb = b % 1024, swz = sb ^ (((sb >> 9) & 1) << 5); R = (st >> 1) * 16 + swz / 64; C = (st & 1) * 32 + (swz % 64) / 2; }

struct Unit { int pm, pn, z, arow, sp; };
struct Gemm { const bf16_t* A; const bf16_t* Bt; int lda, ldb, K; long zA, zB; int krep; };

struct Sched {
    int nM, nN, nwg, G, c, nz, mode;
    __device__ void init(int nM_, int nN_, int G_, int c_, int nz_, int mode_) { nM = nM_; nN = nN_; nwg = nM * nN; G = G_; c = c_; nz = nz_; mode = mode_; }
    __device__ bool next(int i, Unit& u) const {
        const int iz = i % nz, it = i / nz;
        const long L = (long)it * G + c; if (L >= nwg) return false;
        int wgid = (int)L; { const int q = nwg / NXCD, r = nwg % NXCD, xcd = wgid % NXCD, off = wgid / NXCD; wgid = (xcd < r ? xcd * (q + 1) : r * (q + 1) + (xcd - r) * q) + off; }
        const int nig = WGM * nN, gid = wgid / nig, fm = gid * WGM, gsz = (nM - fm) < WGM ? (nM - fm) : WGM;
        u.pm = fm + ((wgid % nig) % gsz); u.pn = (wgid % nig) / gsz; u.z = iz;
        u.sp = 0;
        if (mode == 1) {
            if (u.pm < 128) { const int b = u.pm >> 3, ti = u.pm & 7; u.arow = b * SEQ + ti * 254 - 2; }
            else { u.sp = 1; u.arow = (u.pm - 128) * 8 * SEQ + (SEQ - 32); }
        } else u.arow = u.pm * BM;
        return true;
    }
};

template <class Epi>
__device__ __forceinline__ void gemm_phase(LAS unsigned char* lds, const Gemm g, const Sched& S, const Epi& E) {
    const int tid = tid_opaque(), wid = __builtin_amdgcn_readfirstlane(tid >> 6), lane = tid & 63, wr = wid >> 2, wc = wid & 3, fr = lane & 15, fq = lane >> 4;
    const int K = g.K, nt = (K / BK) * (g.krep > 1 ? 2 : 1), kmask = (g.krep > 1) ? (K / BK - 1) : 0x7fffffff;
    unsigned voffA[2], voffB[2];
#pragma unroll
    for (int i = 0; i < 2; ++i) { int R, C; stage_rc(tid * 16 + i * 8192, R, C); voffA[i] = (unsigned)(R * g.lda + C) * 2u; voffB[i] = (unsigned)(R * g.ldb + C) * 2u; }
    const size_t kstep = (size_t)(BK * 2);
    const size_t hstepA = (size_t)HALF * g.lda * 2, hstepB = (size_t)HALF * g.ldb * 2;
    unsigned voffS[2] = {0u, 0u}; const size_t hstepS = (size_t)4 * SEQ * g.lda * 2;
    if constexpr (Epi::SPECIAL_ROWS) {
#pragma unroll
        for (int i = 0; i < 2; ++i) { int R, C; stage_rc(tid * 16 + i * 8192, R, C); voffS[i] = (unsigned)(((R >> 5) * SEQ + (R & 31)) * g.lda + C) * 2u; }
    }
    const unsigned ldsw = (unsigned)wid * 1024u;
    const int aoff = lds_byte(wr * 64 + fr, fq * 8), boff = lds_byte(wc * 32 + fr, fq * 8);
#define PG8_SA(b, h) (((b) * 2 + (h)) * HTB)
#define PG8_SB(b, h) ((4 + (b) * 2 + (h)) * HTB)
#define PG8_STAGE(bufoff, gbase, voff) do { _Pragma("unroll") for (int _i = 0; _i < 2; ++_i) \
        __builtin_amdgcn_global_load_lds((const unsigned*)((const char*)(gbase) + (voff)[_i]), (LAS unsigned*)(lds + (bufoff) + ldsw + _i * 8192), 16, 0, 0); } while (0)
#define PG8_STAGE_A(bufoff, gbase, spf) do { _Pragma("unroll") for (int _i = 0; _i < 2; ++_i) \
        __builtin_amdgcn_global_load_lds((const unsigned*)((const char*)(gbase) + (Epi::SPECIAL_ROWS && (spf) ? voffS[_i] : voffA[_i])), (LAS unsigned*)(lds + (bufoff) + ldsw + _i * 8192), 16, 0, 0); } while (0)
#define PG8_LDA(dst, b, h) do { _Pragma("unroll") for (int m = 0; m < 4; ++m) _Pragma("unroll") for (int k = 0; k < 2; ++k) dst[m][k] = *(const LAS bf16x8*)(lds + PG8_SA(b, h) + aoff + m * 2048 + k * 1024); } while (0)
#define PG8_LDB(dst, b, h) do { _Pragma("unroll") for (int n = 0; n < 2; ++n) _Pragma("unroll") for (int k = 0; k < 2; ++k) dst[n][k] = *(const LAS bf16x8*)(lds + PG8_SB(b, h) + boff + n * 2048 + k * 1024); } while (0)
#define PG8_MMA(ai, bj, At, Bt) do { __builtin_amdgcn_s_setprio(1); _Pragma("unroll") for (int m = 0; m < 4; ++m) _Pragma("unroll") for (int n = 0; n < 2; ++n) _Pragma("unroll") for (int k = 0; k < 2; ++k) \
        acc[ai][bj][m][n] = __builtin_amdgcn_mfma_f32_16x16x32_bf16(Bt[n][k], At[m][k], acc[ai][bj][m][n], 0, 0, 0); __builtin_amdgcn_s_setprio(0); } while (0)
#define PG8_WAIT_V(n) asm volatile("s_waitcnt vmcnt(" #n ")" ::: "memory")
#define PG8_WAIT_L(n) asm volatile("s_waitcnt lgkmcnt(" #n ")" ::: "memory")
#define PG8_BAR __builtin_amdgcn_s_barrier()
#define PG8_SCHED __builtin_amdgcn_sched_barrier(0)
#define PG8_APTR(u) ((const char*)g.A + ((long)(u).z * g.zA + (long)(u).arow * g.lda) * 2)
#define PG8_BPTR(u) ((const char*)g.Bt + ((long)(u).z * g.zB + (long)(u).pn * BM * g.ldb) * 2)
    Unit cur, nxt; int ui = 0;
    if (!S.next(0, cur)) return;
    f32x4 acc[2][2][4][2];
#pragma unroll
    for (int a = 0; a < 2; ++a)
#pragma unroll
        for (int b = 0; b < 2; ++b)
#pragma unroll
            for (int m = 0; m < 4; ++m)
#pragma unroll
                for (int n = 0; n < 2; ++n) acc[a][b][m][n] = (f32x4){0.f, 0.f, 0.f, 0.f};
    bf16x8 At[4][2], B0[2][2], B1[2][2];
    const char* cA = PG8_APTR(cur); const char* cB = PG8_BPTR(cur);
    bool csp = false; size_t chA = hstepA;
    if constexpr (Epi::SPECIAL_ROWS) { if (cur.sp) { csp = true; chA = hstepS; } }
    PG8_STAGE(PG8_SB(0, 0), cB, voffB); PG8_STAGE(PG8_SB(0, 1), cB + hstepB, voffB); PG8_STAGE_A(PG8_SA(0, 0), cA, csp); PG8_STAGE_A(PG8_SA(0, 1), cA + chA, csp);
    if (wr == 1) PG8_BAR;
    PG8_WAIT_V(2); PG8_BAR;
    PG8_STAGE(PG8_SB(1, 0), cB + kstep, voffB); PG8_STAGE_A(PG8_SA(1, 0), cA + kstep, csp); PG8_STAGE(PG8_SB(1, 1), cB + hstepB + kstep, voffB);
    PG8_WAIT_V(6); PG8_BAR;
    for (;;) {
        const bool has_next = S.next(ui + 1, nxt);
        const char* nA = has_next ? PG8_APTR(nxt) : cA; const char* nB = has_next ? PG8_BPTR(nxt) : cB;
        bool nsp = csp; size_t nhA = chA;
        if constexpr (Epi::SPECIAL_ROWS) { if (has_next) { nsp = nxt.sp != 0; nhA = nsp ? hstepS : hstepA; } }
#pragma unroll 1
        for (int t = 0; t < nt; t += 2) {
            const bool last = (t == nt - 2);
            const char* a1 = cA + (size_t)((t + 1) & kmask) * kstep;
            const char* a2 = last ? nA : cA + (size_t)((t + 2) & kmask) * kstep; const char* b2 = last ? nB : cB + (size_t)((t + 2) & kmask) * kstep;
            const char* a3 = a2 + kstep; const char* b3 = b2 + kstep;
            const bool sp2 = last ? nsp : csp; const size_t hA2 = last ? nhA : chA;
            PG8_LDB(B0, 0, 0); PG8_LDB(B1, 0, 1); PG8_SCHED; PG8_LDA(At, 0, 0); PG8_STAGE_A(PG8_SA(1, 1), a1 + chA, csp);
            PG8_WAIT_V(8); PG8_WAIT_L(0); PG8_BAR; PG8_MMA(0, 0, At, B0); PG8_MMA(0, 1, At, B1); PG8_BAR; PG8_SCHED;
            PG8_LDA(At, 0, 1); PG8_STAGE(PG8_SB(0, 0), b2, voffB); PG8_STAGE(PG8_SB(0, 1), b2 + hstepB, voffB); PG8_STAGE_A(PG8_SA(0, 0), a2, sp2);
            PG8_WAIT_V(8); PG8_WAIT_L(0); PG8_BAR; PG8_MMA(1, 0, At, B0); PG8_MMA(1, 1, At, B1); PG8_BAR; PG8_SCHED;
            PG8_LDB(B0, 1, 0); PG8_LDB(B1, 1, 1); PG8_SCHED; PG8_LDA(At, 1, 0); PG8_STAGE_A(PG8_SA(0, 1), a2 + hA2, sp2);
            PG8_WAIT_V(8); PG8_WAIT_L(0); PG8_BAR; PG8_MMA(0, 0, At, B0); PG8_MMA(0, 1, At, B1); PG8_BAR; PG8_SCHED;
            PG8_LDA(At, 1, 1); PG8_STAGE(PG8_SB(1, 0), b3, voffB); PG8_STAGE(PG8_SB(1, 1), b3 + hstepB, voffB); PG8_STAGE_A(PG8_SA(1, 0), a3, sp2);
            PG8_WAIT_V(8); PG8_WAIT_L(0); PG8_BAR; PG8_MMA(1, 0, At, B0); PG8_MMA(1, 1, At, B1); PG8_BAR; PG8_SCHED;
        }
        if (wr == 0) PG8_BAR;
        E(acc, cur, wr, wc, fr, fq, lds + STAGE_BYTES);
        if (!has_next) break;
        if constexpr (!Epi::KEEP_ACC) {
#pragma unroll
        for (int a = 0; a < 2; ++a)
#pragma unroll
            for (int b = 0; b < 2; ++b)
#pragma unroll
                for (int m = 0; m < 4; ++m)
#pragma unroll
                    for (int n = 0; n < 2; ++n) acc[a][b][m][n] = (f32x4){0.f, 0.f, 0.f, 0.f};
        }
        cur = nxt; cA = nA; cB = nB; ++ui; csp = nsp; chA = nhA;
        if (wr == 1) PG8_BAR;
    }
    PG8_WAIT_V(0);
    PG8_BAR;
#undef PG8_SA
#undef PG8_SB
#undef PG8_STAGE
#undef PG8_STAGE_A
#undef PG8_LDA
#undef PG8_LDB
#undef PG8_MMA
#undef PG8_WAIT_V
#undef PG8_WAIT_L
#undef PG8_BAR
#undef PG8_SCHED
#undef PG8_APTR
#undef PG8_BPTR
}
}
using pg8::Unit;
typedef f32x4 AccT[2][2][4][2];

struct EpiIn1 {
    static constexpr bool KEEP_ACC = false, SPECIAL_ROWS = false;
    const float* ssqx; bf16_t *cq, *ckv, *qf, *kf, *vf, *ub; float *ssq_cq, *ssq_ckv, *ssq_kr, *kr_rot, *logf;
    const float *cosT, *sinT, *gk_mla, *gq_fox, *gk_fox, *fbias;
    __device__ __forceinline__ void operator()(AccT& acc, const Unit& u, int wr, int wc, int fr, int fq, LAS unsigned char*) const {
        const long row0 = (long)u.pm * 256 + wr * 64 + fr;
        float rsa[2][4]; row_scales<16>(rsa, ssqx, row0, fq, 1.f / 1024.f);
#pragma unroll
        for (int ai = 0; ai < 2; ++ai)
#pragma unroll
            for (int m = 0; m < 4; ++m) {
                const long row = row0 + ai * 128 + m * 16;
                const float rs = rsa[ai][m];
                f32x4 v[2][2];
#pragma unroll
                for (int bj = 0; bj < 2; ++bj)
#pragma unroll
                    for (int n = 0; n < 2; ++n) v[bj][n] = acc[ai][bj][m][n] * rs;
                const int cl = wc * 32 + 8 * fq;
                if (u.pn == 0 || u.pn == 2 || u.pn == 5 || u.pn == 6) {
                    bf16_t* dst = (u.pn == 0) ? cq + row * 384 : (u.pn == 2) ? ckv + row * 256 : (u.pn == 5) ? vf + row * 256 : ub + row * 256;
                    float ss = 0.f;
#pragma unroll
                    for (int bj = 0; bj < 2; ++bj) { store8(dst + bj * 128 + cl, v[bj][0], v[bj][1]); ss += dot4(v[bj][0]) + dot4(v[bj][1]); }
                    if (u.pn == 0 || u.pn == 2) { ss = red_fq(ss); if (fq == 0) { if (u.pn == 0) ssq_cq[row * 8 + wc] = ss; else ssq_ckv[row * 4 + wc] = ss; } }
                } else if (u.pn == 1) {
                    float ss = 0.f;
                    store8(cq + row * 384 + 256 + cl, v[0][0], v[0][1]); ss += dot4(v[0][0]) + dot4(v[0][1]);
                    ss = red_fq(ss); if (fq == 0) ssq_cq[row * 8 + 4 + wc] = ss;
                    if (wc == 0) {
                        float sk = red_fq(dot4(v[1][0]) + dot4(v[1][1])); if (fq == 0) ssq_kr[row] = sk;
                        const f32x4 g1 = *(const f32x4*)(gk_mla + 64 + 4 * fq), g2 = *(const f32x4*)(gk_mla + 80 + 4 * fq);
                        const f32x4 cs = *(const f32x4*)(cosT + row * 16 + 4 * fq), sn = *(const f32x4*)(sinT + row * 16 + 4 * fq);
                        const f32x4 a1 = v[1][0] * g1, a2 = v[1][1] * g2;
                        *(f32x4*)(kr_rot + row * 32 + 4 * fq) = a1 * cs - a2 * sn;
                        *(f32x4*)(kr_rot + row * 32 + 16 + 4 * fq) = a2 * cs + a1 * sn;
                    } else if (wc == 1 && fq == 0) {
                        const f32x4 fb = *(const f32x4*)fbias; f32x4 z = v[1][0] + fb, o;
#pragma unroll
                        for (int i = 0; i < 4; ++i) o[i] = fminf(z[i], 0.f) - 0.6931471805599453f * __builtin_amdgcn_logf(1.f + __builtin_amdgcn_exp2f(-fabsf(z[i]) * LOG2E));
                        *(f32x4*)(logf + row * 4) = o;
                    }
                } else {
                    float ss = 0.f;
#pragma unroll
                    for (int bj = 0; bj < 2; ++bj)
#pragma unroll
                        for (int n = 0; n < 2; ++n) ss += dot4(v[bj][n]);
                    ss = red_fq(ss);
                    const float rh = rsqrtf(ss * (1.f / 64.f) + EPS) * (u.pn == 3 ? 0.125f * LOG2E : 1.f);
                    const float* gg = (u.pn == 3) ? gq_fox : gk_fox; bf16_t* dst = ((u.pn == 3) ? qf : kf) + row * 256 + wc * 64 + 8 * fq;
#pragma unroll
                    for (int bj = 0; bj < 2; ++bj) { const f32x4 g0 = *(const f32x4*)(gg + 32 * bj + 8 * fq), g1 = *(const f32x4*)(gg + 32 * bj + 8 * fq + 4); store8(dst + 32 * bj, v[bj][0] * g0 * rh, v[bj][1] * g1 * rh); }
                }
            }
    }
};
struct EpiGates {
    static constexpr bool KEEP_ACC = false, SPECIAL_ROWS = false;
    const float* ssqx; bf16_t* gates;
    __device__ __forceinline__ void operator()(AccT& acc, const Unit& u, int wr, int wc, int fr, int fq, LAS unsigned char*) const {
        const long row0 = (long)u.pm * 256 + wr * 64 + fr;
        const size_t tb = ((size_t)(u.pm * 12 + u.pn) * 8 + (wr * 4 + wc)) * 16; const int lane = fq * 16 + fr;
        float rsa[2][4]; row_scales<16>(rsa, ssqx, row0, fq, 1.f / 1024.f);
#pragma unroll
        for (int ai = 0; ai < 2; ++ai)
#pragma unroll
            for (int m = 0; m < 4; ++m) {
                const float rs = rsa[ai][m] * -LOG2E;
#define SG_(t) __builtin_amdgcn_rcpf(1.f + __builtin_amdgcn_exp2f(min2f(t, 19.931568f)))
#pragma unroll
                for (int bj = 0; bj < 2; ++bj) { const f32x4 v0 = acc[ai][bj][m][0] * rs, v1 = acc[ai][bj][m][1] * rs; u32x4 w;
                    w.x = pk2(SG_(v0.x), SG_(v0.y)); w.y = pk2(SG_(v0.z), SG_(v0.w)); w.z = pk2(SG_(v1.x), SG_(v1.y)); w.w = pk2(SG_(v1.z), SG_(v1.w));
#undef SG_
                    *(u32x4*)(gates + ((tb + (ai * 4 + m) * 2 + bj) * 64 + lane) * 8) = w; }
            }
    }
};
struct EpiUq {
    static constexpr bool KEEP_ACC = false, SPECIAL_ROWS = false;
    const float* ssq_cq; bf16_t* qm; float *ssq_qn, *ssq_qr; const float *cosT, *sinT, *gq;
    __device__ __forceinline__ void operator()(AccT& acc, const Unit& u, int wr, int wc, int fr, int fq, LAS unsigned char*) const {
        const long row0 = (long)u.pm * 256 + wr * 64 + fr;
        float rsa[2][4]; row_scales<8>(rsa, ssq_cq, row0, fq, 1.f / 384.f);
        if (u.pn == 0) {
            f32x4 gv[2][2];
#pragma unroll
            for (int bj = 0; bj < 2; ++bj)
#pragma unroll
                for (int n = 0; n < 2; ++n) gv[bj][n] = *(const f32x4*)(gq + 32 * bj + 8 * fq + 4 * n);
#pragma unroll
            for (int ai = 0; ai < 2; ++ai)
#pragma unroll
                for (int m = 0; m < 4; ++m) { const long row = row0 + ai * 128 + m * 16; const float rs = rsa[ai][m]; float ss = 0.f;
#pragma unroll
                    for (int bj = 0; bj < 2; ++bj) { const f32x4 v0 = acc[ai][bj][m][0] * rs, v1 = acc[ai][bj][m][1] * rs; ss += dot4(v0) + dot4(v1); store8(qm + row * 384 + wc * 96 + 32 * bj + 8 * fq, v0 * gv[bj][0], v1 * gv[bj][1]); }
                    ss = red_fq(ss); if (fq == 0) ssq_qn[row * 4 + wc] = ss; }
        } else {
            const f32x4 g1 = *(const f32x4*)(gq + 64 + 4 * fq), g2 = *(const f32x4*)(gq + 80 + 4 * fq);
#pragma unroll
            for (int ai = 0; ai < 2; ++ai) {
                f32x4 cs[4], sn[4];
#pragma unroll
                for (int m = 0; m < 4; ++m) { const long row = row0 + ai * 128 + m * 16; cs[m] = *(const f32x4*)(cosT + row * 16 + 4 * fq); sn[m] = *(const f32x4*)(sinT + row * 16 + 4 * fq); }
#pragma unroll
                for (int m = 0; m < 4; ++m) { const long row = row0 + ai * 128 + m * 16; const float rs = rsa[ai][m];
                    const f32x4 x1 = acc[ai][0][m][0] * rs, x2 = acc[ai][0][m][1] * rs;
                    float ss = red_fq(dot4(x1) + dot4(x2)); if (fq == 0) ssq_qr[row * 4 + wc] = ss;
                    const f32x4 a1 = x1 * g1, a2 = x2 * g2;
                    store4(qm + row * 384 + wc * 96 + 64 + 4 * fq, a1 * cs[m] - a2 * sn[m]);
                    store4(qm + row * 384 + wc * 96 + 80 + 4 * fq, a2 * cs[m] + a1 * sn[m]); }
                asm volatile("" ::: "memory");
            }
        }
    }
};
struct EpiUkv {
    static constexpr bool KEEP_ACC = false, SPECIAL_ROWS = false;
    const float *ssq_ckv, *ssq_kr, *kr_rot, *gk; bf16_t *km, *vm;
    __device__ __forceinline__ void operator()(AccT& acc, const Unit& u, int wr, int wc, int fr, int fq, LAS unsigned char*) const {
        const long row0 = (long)u.pm * 256 + wr * 64 + fr;
        float rsa[2][4]; row_scales<4>(rsa, ssq_ckv, row0, fq, 1.f / 256.f);
        if (u.pn == 0) {
            f32x4 gv[2][2];
#pragma unroll
            for (int bj = 0; bj < 2; ++bj)
#pragma unroll
                for (int n = 0; n < 2; ++n) gv[bj][n] = *(const f32x4*)(gk + 32 * bj + 8 * fq + 4 * n);
#pragma unroll
            for (int ai = 0; ai < 2; ++ai) {
                float skr[4]; f32x4 kr0[4], kr1[4];
#pragma unroll
                for (int m = 0; m < 4; ++m) { const long row = row0 + ai * 128 + m * 16; skr[m] = ssq_kr[row]; kr0[m] = *(const f32x4*)(kr_rot + row * 32 + 8 * fq); kr1[m] = *(const f32x4*)(kr_rot + row * 32 + 8 * fq + 4); }
#pragma unroll
                for (int m = 0; m < 4; ++m) {
                    const long row = row0 + ai * 128 + m * 16; const float rs = rsa[ai][m];
                    f32x4 v[2][2]; float ss = 0.f;
#pragma unroll
                    for (int bj = 0; bj < 2; ++bj)
#pragma unroll
                        for (int n = 0; n < 2; ++n) { v[bj][n] = acc[ai][bj][m][n] * rs; ss += dot4(v[bj][n]); }
                    ss = red_fq(ss) + skr[m];
                    const float rk = rsqrtf(ss * (1.f / 96.f) + EPS);
#pragma unroll
                    for (int bj = 0; bj < 2; ++bj) store8(km + row * 384 + wc * 96 + 32 * bj + 8 * fq, v[bj][0] * gv[bj][0] * rk, v[bj][1] * gv[bj][1] * rk);
                    const f32x4 r0 = kr0[m] * rk, r1 = kr1[m] * rk;
                    u32x4 w; w.x = pk2(r0.x, r0.y); w.y = pk2(r0.z, r0.w); w.z = pk2(r1.x, r1.y); w.w = pk2(r1.z, r1.w);
                    *(u32x4*)(km + row * 384 + wc * 96 + 64 + 8 * fq) = w;
                }
                asm volatile("" ::: "memory");
            }
        } else {
#pragma unroll
            for (int ai = 0; ai < 2; ++ai)
#pragma unroll
                for (int m = 0; m < 4; ++m) { const long row = row0 + ai * 128 + m * 16; const float rs = rsa[ai][m];
#pragma unroll
                    for (int bj = 0; bj < 2; ++bj) { const f32x4 y0 = acc[ai][bj][m][0] * rs, y1 = acc[ai][bj][m][1] * rs; u32x4 w; w.x = pk2(y0.x, y0.y); w.y = pk2(y0.z, y0.w); w.z = pk2(y1.x, y1.y); w.w = pk2(y1.z, y1.w);
                        *(u32x4*)(vm + row * 256 + bj * 128 + wc * 32 + 8 * fq) = w; } }
        }
    }
};
struct EpiGlu {
    static constexpr bool KEEP_ACC = false, SPECIAL_ROWS = false;
    const bf16_t* y2; const float* bglu; bf16_t* os5;
    __device__ __forceinline__ void operator()(AccT& acc, const Unit& u, int wr, int wc, int fr, int fq, LAS unsigned char*) const {
        const long row0 = (long)u.pm * 256 + wr * 64 + fr; const int colb = wc * 32 + 8 * fq;
        f32x4 bv[2][2];
#pragma unroll
        for (int bj = 0; bj < 2; ++bj)
#pragma unroll
            for (int n = 0; n < 2; ++n) bv[bj][n] = *(const f32x4*)(bglu + bj * 128 + 4 * n + colb);
#pragma unroll
        for (int ai = 0; ai < 2; ++ai) {
            u32x4 yw[4][2];
#pragma unroll
            for (int m = 0; m < 4; ++m)
#pragma unroll
                for (int bj = 0; bj < 2; ++bj) yw[m][bj] = *(const u32x4*)(y2 + (row0 + ai * 128 + m * 16) * 256 + bj * 128 + colb);
#pragma unroll
            for (int m = 0; m < 4; ++m)
#pragma unroll
                for (int bj = 0; bj < 2; ++bj) { const u32x4 w = yw[m][bj];
                    const f32x4 y0 = (f32x4){__uint_as_float(w.x << 16), __uint_as_float(w.x & 0xffff0000u), __uint_as_float(w.y << 16), __uint_as_float(w.y & 0xffff0000u)};
                    const f32x4 y1 = (f32x4){__uint_as_float(w.z << 16), __uint_as_float(w.z & 0xffff0000u), __uint_as_float(w.w << 16), __uint_as_float(w.w & 0xffff0000u)};
                    const f32x4 z0 = acc[ai][bj][m][0] + bv[bj][0], z1 = acc[ai][bj][m][1] + bv[bj][1]; f32x4 o0, o1;
#pragma unroll
                    for (int i = 0; i < 4; ++i) { o0[i] = y0[i] * sigmoidf_(z0[i]); o1[i] = y1[i] * sigmoidf_(z1[i]); }
                    u32x4 o; o.x = pk2(o0.x, o0.y); o.y = pk2(o0.z, o0.w); o.z = pk2(o1.x, o1.y); o.w = pk2(o1.z, o1.w);
                    *(u32x4*)(os5 + (row0 + ai * 128 + m * 16) * 256 + bj * 128 + colb) = o; }
            asm volatile("" ::: "memory");
        }
    }
};
struct EpiWb {
    static constexpr bool KEEP_ACC = true, SPECIAL_ROWS = false;
    const bf16_t* gates; bf16_t* merged;
    static __device__ __forceinline__ void unpack8(const u32x4 w, f32x4& a, f32x4& b) {
        a.x = __uint_as_float(w.x << 16); a.y = __uint_as_float(w.x & 0xffff0000u); a.z = __uint_as_float(w.y << 16); a.w = __uint_as_float(w.y & 0xffff0000u);
        b.x = __uint_as_float(w.z << 16); b.y = __uint_as_float(w.z & 0xffff0000u); b.z = __uint_as_float(w.w << 16); b.w = __uint_as_float(w.w & 0xffff0000u);
    }
    __device__ __forceinline__ void operator()(AccT& acc, const Unit& u, int wr, int wc, int fr, int fq, LAS unsigned char*) const {
        const long row0 = (long)u.pm * 256 + wr * 64 + fr;
        const size_t tb = ((size_t)(u.pm * 12 + u.z * 4 + u.pn) * 8 + (wr * 4 + wc)) * 16; const int lane = fq * 16 + fr;
        constexpr size_t ZSTEP = (size_t)4 * 8 * 16 * 64 * 8;
        const bool more = (u.z < 2);
#pragma unroll
        for (int ai = 0; ai < 2; ++ai) {
            u32x4 gw[8], nw[8];
#pragma unroll
            for (int j = 0; j < 8; ++j) { const bf16_t* gp = gates + ((tb + ai * 8 + j) * 64 + lane) * 8; gw[j] = *(const u32x4*)gp; nw[j] = *(const u32x4*)(gp + (more ? ZSTEP : 0)); }
#pragma unroll
            for (int m = 0; m < 4; ++m)
#pragma unroll
                for (int bj = 0; bj < 2; ++bj) {
                    f32x4 g0, g1; unpack8(gw[m * 2 + bj], g0, g1);
                    if (more) {
                        f32x4 h0, h1; unpack8(nw[m * 2 + bj], h0, h1);
#pragma unroll
                        for (int i = 0; i < 4; ++i) { acc[ai][bj][m][0][i] *= g0[i] * __builtin_amdgcn_rcpf(h0[i]); acc[ai][bj][m][1][i] *= g1[i] * __builtin_amdgcn_rcpf(h1[i]); }
                    } else {
                        const long off = (row0 + ai * 128 + m * 16) * 1024 + u.pn * 256 + bj * 128 + wc * 32 + 8 * fq;
                        const f32x4 y0 = acc[ai][bj][m][0] * g0, y1 = acc[ai][bj][m][1] * g1; u32x4 w; w.x = pk2(y0.x, y0.y); w.y = pk2(y0.z, y0.w); w.z = pk2(y1.x, y1.y); w.w = pk2(y1.z, y1.w);
                        *(u32x4*)(merged + off) = w;
                        acc[ai][bj][m][0] = (f32x4){0.f, 0.f, 0.f, 0.f}; acc[ai][bj][m][1] = (f32x4){0.f, 0.f, 0.f, 0.f};
                    }
                }
            asm volatile("" ::: "memory");
        }
    }
};
struct EpiRes {
    static constexpr bool KEEP_ACC = false, SPECIAL_ROWS = false;
    const float* xin; float* xout; bf16_t* xb; float* ssqx;
    __device__ __forceinline__ void operator()(AccT& acc, const Unit& u, int wr, int wc, int fr, int fq, LAS unsigned char*) const {
        const long row0 = (long)u.pm * 256 + wr * 64 + fr; const int colb = u.pn * 256 + wc * 32 + 8 * fq;
#pragma unroll
        for (int ai = 0; ai < 2; ++ai) {
            f32x4 xo[4][2][2];
            if (xin) {
#pragma unroll
                for (int m = 0; m < 4; ++m)
#pragma unroll
                    for (int bj = 0; bj < 2; ++bj)
#pragma unroll
                        for (int n = 0; n < 2; ++n) xo[m][bj][n] = *(const f32x4*)(xin + (row0 + ai * 128 + m * 16) * 1024 + colb + bj * 128 + 4 * n);
            } else {
                u32x4 xw[4][2];
#pragma unroll
                for (int m = 0; m < 4; ++m)
#pragma unroll
                    for (int bj = 0; bj < 2; ++bj) xw[m][bj] = *(const u32x4*)(xb + (row0 + ai * 128 + m * 16) * 1024 + colb + bj * 128);
#pragma unroll
                for (int m = 0; m < 4; ++m)
#pragma unroll
                    for (int bj = 0; bj < 2; ++bj) { const u32x4 w = xw[m][bj];
                        xo[m][bj][0] = (f32x4){__uint_as_float(w.x << 16), __uint_as_float(w.x & 0xffff0000u), __uint_as_float(w.y << 16), __uint_as_float(w.y & 0xffff0000u)};
                        xo[m][bj][1] = (f32x4){__uint_as_float(w.z << 16), __uint_as_float(w.z & 0xffff0000u), __uint_as_float(w.w << 16), __uint_as_float(w.w & 0xffff0000u)}; }
            }
#pragma unroll
            for (int m = 0; m < 4; ++m) {
                const long row = row0 + ai * 128 + m * 16; float ss = 0.f;
#pragma unroll
                for (int bj = 0; bj < 2; ++bj) { const long off = row * 1024 + colb + bj * 128;
                    const f32x4 x0 = xo[m][bj][0] + acc[ai][bj][m][0], x1 = xo[m][bj][1] + acc[ai][bj][m][1];
                    u32x4 w; w.x = pk2(x0.x, x0.y); w.y = pk2(x0.z, x0.w); w.z = pk2(x1.x, x1.y); w.w = pk2(x1.z, x1.w);
                    *(u32x4*)(xb + off) = w; ss += dot4(x0) + dot4(x1);
                    if (xout) { *(f32x4*)(xout + off) = x0; *(f32x4*)(xout + off + 4) = x1; } }
                ss = red_fq(ss); if (fq == 0) ssqx[row * 16 + u.pn * 4 + wc] = ss;
            }
            asm volatile("" ::: "memory");
        }
    }
};
struct EpiUp {
    static constexpr bool KEEP_ACC = false, SPECIAL_ROWS = true;
    const float* ssqx; const float* cw; bf16_t* act;
    __device__ __forceinline__ long tok_row(const Unit& u, int ai, int wr, int m, int fr) const {
        if (u.sp) return (long)((u.pm - 128) * 8 + 4 * ai + 2 * wr + (m >> 1)) * SEQ + (SEQ - 32) + 16 * (m & 1) + fr;
        const int t = (u.pm & 7) * 254 - 2 + ai * 128 + wr * 64 + m * 16 + fr;
        return t < 0 ? -1 : (long)(u.pm >> 3) * SEQ + t;
    }
    __device__ __forceinline__ void operator()(AccT& acc, const Unit& u, int wr, int wc, int fr, int fq, LAS unsigned char* ldsx) const {
        asm volatile("" : "+v"(fr), "+v"(fq));
        { float tt[2][4];
#pragma unroll
        for (int ai = 0; ai < 2; ++ai)
#pragma unroll
            for (int m = 0; m < 4; ++m) { const long tr = tok_row(u, ai, wr, m, fr);
                const f32x4 v = *(const f32x4*)(ssqx + (tr < 0 ? 0 : tr) * 16 + 4 * fq); tt[ai][m] = (v.x + v.y) + (v.z + v.w); }
#pragma unroll
        for (int ai = 0; ai < 2; ++ai)
#pragma unroll
            for (int m = 0; m < 4; ++m) {
                const bool ok = tok_row(u, ai, wr, m, fr) >= 0;
                const float rs = ok ? rsqrtf(red_fq(tt[ai][m]) * (1.f / 1024.f) + EPS) * (PROBE_KREP == 8 ? 0.5f : 1.f) : 0.f;
#pragma unroll
                for (int bj = 0; bj < 2; ++bj)
#pragma unroll
                    for (int n = 0; n < 2; ++n) acc[ai][bj][m][n] *= rs;
            } }
        LAS float* xch = (LAS float*)ldsx;
        if (fr >= 14) {
#pragma unroll
            for (int ai = 0; ai < 2; ++ai) { const int s = ai * 2 + wr;
#pragma unroll
                for (int bj = 0; bj < 2; ++bj)
#pragma unroll
                    for (int n = 0; n < 2; ++n) *(LAS f32x4*)(xch + ((s * 2 + (fr - 14)) * 256 + bj * 128 + wc * 32 + n * 16 + 4 * fq)) = acc[ai][bj][3][n]; }
        }
        asm volatile("s_waitcnt lgkmcnt(0)" ::: "memory"); __builtin_amdgcn_s_barrier(); asm volatile("" ::: "memory");
        const bool hi1 = (fr == 15), hi2 = (fr >= 14);
        const int ch = u.pn * 128 + wc * 32 + 8 * fq;
        f32x4 wg[2][3], wv[2][3];
#pragma unroll
        for (int n = 0; n < 2; ++n)
#pragma unroll
            for (int j = 0; j < 3; ++j) { wg[n][j] = *(const f32x4*)(cw + j * 5632 + ch + 4 * n); wv[n][j] = *(const f32x4*)(cw + j * 5632 + DFF + ch + 4 * n); }
#pragma unroll
        for (int ai = 0; ai < 2; ++ai) {
            const int s = ai * 2 + wr;
            f32x4 pg[2], pv[2];
#pragma unroll
            for (int n = 0; n < 2; ++n) { pg[n] = (f32x4){0.f, 0.f, 0.f, 0.f}; pv[n] = pg[n]; }
            if (s > 0 && fr >= 14) {
#pragma unroll
                for (int n = 0; n < 2; ++n) { const LAS float* q = xch + (((s - 1) * 2 + (fr - 14)) * 256 + wc * 32 + n * 16 + 4 * fq); pg[n] = *(const LAS f32x4*)q; pv[n] = *(const LAS f32x4*)(q + 128); }
            }
#pragma unroll
            for (int m = 0; m < 4; ++m) {
                u32x4 w;
#pragma unroll
                for (int n = 0; n < 2; ++n) {
                    const f32x4 cg = acc[ai][0][m][n], cv = acc[ai][1][m][n]; f32x4 o;
                    float og[4];
                    { float s1[4], s2[4];
#pragma unroll
                      for (int i = 0; i < 4; ++i) { s1[i] = hi1 ? pg[n][i] : cg[i]; s2[i] = hi2 ? pg[n][i] : cg[i]; }
#pragma unroll
                      for (int i = 0; i < 4; ++i) { s1[i] = dpp_ror1(s1[i]); s2[i] = dpp_ror2(s2[i]); }
#pragma unroll
                      for (int i = 0; i < 4; ++i) og[i] = wg[n][2][i] * cg[i] + wg[n][1][i] * s1[i] + wg[n][0][i] * s2[i]; }
                    { float s1[4], s2[4];
#pragma unroll
                      for (int i = 0; i < 4; ++i) { s1[i] = hi1 ? pv[n][i] : cv[i]; s2[i] = hi2 ? pv[n][i] : cv[i]; }
#pragma unroll
                      for (int i = 0; i < 4; ++i) { s1[i] = dpp_ror1(s1[i]); s2[i] = dpp_ror2(s2[i]); }
#pragma unroll
                      for (int i = 0; i < 4; ++i) { const float ov = wv[n][2][i] * cv[i] + wv[n][1][i] * s1[i] + wv[n][0][i] * s2[i]; o[i] = og[i] * sigmoidf_(og[i]) * ov; } }
                    w[2 * n] = pk2(o[0], o[1]); w[2 * n + 1] = pk2(o[2], o[3]);
                    pg[n] = cg; pv[n] = cv;
                }
                const bool st = u.sp ? ((m & 1) != 0) : (ai * 128 + wr * 64 + m * 16 + fr >= 2);
                if (st) *(u32x4*)(act + tok_row(u, ai, wr, m, fr) * DFF + ch) = w;
            }
        }
    }
};

template <bool MLA>
__device__ __forceinline__ void attn_unit(LAS unsigned char* lds, const bf16_t* Q, const bf16_t* Kp, const bf16_t* V, bf16_t* O, const float* ssq_qn, const float* ssq_qr, const float* cl, int b, int h, int qb) {
    constexpr int DK = MLA ? 96 : 64, NC = DK / 16, KP = MLA ? DK * 2 + 16 : DK * 2 + 32 + 16, KSEG = DK / 8, LDQ = MLA ? 384 : 256;
    constexpr int KBUF = 64 * 208, VP = 192, VBUF = 64 * VP, VOFF = 2 * KBUF, CKOFF = VOFF + 2 * VBUF;
    const int tid = tid_opaque(), w = tid >> 6, lane = tid & 63, r = lane & 31, hh = lane >> 5;
    const long rowb = (long)b * SEQ;
    const long qrow = rowb + qb * 256 + w * 32 + r;
    bf16x8 qfr[NC];
#pragma unroll
    for (int c = 0; c < NC; ++c) qfr[c] = *(const bf16x8*)(Q + qrow * LDQ + h * DK + 16 * c + 8 * hh);
    if (MLA) {
        const float s = rsqrtf((ssq_qn[qrow * 4 + h] + ssq_qr[qrow * 4 + h]) * (1.f / 96.f) + EPS) * (0.10206207261596574f * LOG2E);
#pragma unroll
        for (int c = 0; c < NC; ++c) { u32x4 wv = __builtin_bit_cast(u32x4, qfr[c]);
#pragma unroll
            for (int j = 0; j < 4; ++j) wv[j] = pk2(__uint_as_float(wv[j] << 16) * s, __uint_as_float(wv[j] & 0xffff0000u) * s);
            qfr[c] = __builtin_bit_cast(bf16x8, wv); }
    }
    const int ntile = 4 * (qb + 1);
    const int tq_lo = qb * 256 + w * 32, tq = tq_lo + r, tq_hi = tq_lo + 31;
    float m_run = -1e30f, l_run = 0.f;
    f32x16 o0, o1;
#pragma unroll
    for (int i = 0; i < 16; ++i) { o0[i] = 0.f; o1[i] = 0.f; }
    u32x4 kst0, kst1 = (u32x4){0, 0, 0, 0}, vst; float cst = 0.f;
    const int kr0 = tid / KSEG, ksg0 = tid % KSEG, kr1 = (tid + 512) / KSEG, ksg1 = (tid + 512) % KSEG;
    const int vkv = tid >> 3, vds = tid & 7;
    const bf16_t* kq0 = Kp + (rowb + kr0) * LDQ + h * DK + 8 * ksg0; const bf16_t* kq1 = Kp + (rowb + kr1) * LDQ + h * DK + 8 * ksg1;
    const bf16_t* vq = V + (rowb + vkv) * 256 + h * 64 + 8 * vds; const float* cq_ = cl + (rowb + (tid & 63)) * 4 + h;
#define AT_LOAD(j) do { \
        kst0 = *(const u32x4*)kq0; kq0 += 64 * LDQ; \
        if (MLA && tid < 256) { kst1 = *(const u32x4*)kq1; kq1 += 64 * LDQ; } \
        vst = *(const u32x4*)vq; vq += 64 * 256; \
        if (!MLA && tid < 64) { cst = -*cq_; cq_ += 64 * 4; } } while (0)
#define AT_WRITE(buf) do { \
        *(LAS u32x4*)(lds + (buf) * KBUF + kr0 * KP + ksg0 * 16) = kst0; \
        if (MLA && tid < 256) *(LAS u32x4*)(lds + (buf) * KBUF + kr1 * KP + ksg1 * 16) = kst1; \
        *(LAS u32x4*)(lds + VOFF + (buf) * VBUF + vkv * VP + vds * 16) = vst; \
        if (!MLA && tid < 64) { const unsigned hi_ = pk2(cst, 0.f) & 0xffffu; const unsigned lo_ = pk2(cst - __uint_as_float(hi_ << 16), 0.f) & 0xffffu; \
            LAS u32x4* ap_ = (LAS u32x4*)(lds + (buf) * KBUF + tid * KP + 128); unsigned z_ = 0u; asm volatile("" : "+v"(z_)); ap_[0] = (u32x4){hi_ | (lo_ << 16), z_, z_, z_}; ap_[1] = (u32x4){z_, z_, z_, z_}; } } while (0)
    AT_LOAD(0); AT_WRITE(0); AT_LOAD(1); __syncthreads();
    for (int j = 0; j < ntile; ++j) {
        const int buf = j & 1;
        if (j + 1 < ntile) { AT_WRITE(buf ^ 1); if (j + 2 < ntile) AT_LOAD(j + 2); }
        if (64 * j <= tq_hi) {
            const LAS unsigned char* kb = lds + buf * KBUF + r * KP + hh * 16;
            f32x16 p0, p1;
#pragma unroll
            for (int i = 0; i < 16; ++i) { p0[i] = 0.f; p1[i] = 0.f; }
            if (!MLA) {
                unsigned zq = 0u; asm volatile("" : "+v"(zq)); const u32x4 qaw = (u32x4){hh == 0 ? 0x3f803f80u : zq, zq, zq, zq}; const bf16x8 qaug = __builtin_bit_cast(bf16x8, qaw);
                const bf16x8 a0 = *(const LAS bf16x8*)(kb + 128), a1 = *(const LAS bf16x8*)(kb + 32 * KP + 128);
                p0 = __builtin_amdgcn_mfma_f32_32x32x16_bf16(a0, qaug, p0, 0, 0, 0);
                p1 = __builtin_amdgcn_mfma_f32_32x32x16_bf16(a1, qaug, p1, 0, 0, 0);
            }
#pragma unroll
            for (int c = 0; c < NC; ++c) {
                const bf16x8 a0 = *(const LAS bf16x8*)(kb + c * 32), a1 = *(const LAS bf16x8*)(kb + 32 * KP + c * 32);
                p0 = __builtin_amdgcn_mfma_f32_32x32x16_bf16(a0, qfr[c], p0, 0, 0, 0);
                p1 = __builtin_amdgcn_mfma_f32_32x32x16_bf16(a1, qfr[c], p1, 0, 0, 0);
            }
            if (64 * j + 63 > tq_lo) {
#pragma unroll
                for (int rg = 0; rg < 16; ++rg) { const int kv = 64 * j + (rg & 3) + 8 * (rg >> 2) + 4 * hh;
                    if (kv > tq) p0[rg] = -1e30f; if (kv + 32 > tq) p1[rg] = -1e30f; }
            }
            float mxa = max3f(p0[0], p0[1], p1[0]), mxb = max3f(p0[2], p0[3], p1[1]); mxa = max3f(mxa, p1[2], p1[3]);
#pragma unroll
            for (int i = 4; i < 16; i += 4) { mxa = max3f(mxa, p0[i], p0[i + 1]); mxb = max3f(mxb, p0[i + 2], p0[i + 3]); mxa = max3f(mxa, p1[i], p1[i + 1]); mxb = max3f(mxb, p1[i + 2], p1[i + 3]); }
            float mx = max2f(mxa, mxb);
            mx = max2f(mx, __shfl_xor(mx, 32));
            const float m_new = max2f(m_run, mx);
            float ls = 0.f;
#pragma unroll
            for (int i = 0; i < 16; ++i) { p0[i] = __builtin_amdgcn_exp2f(p0[i] - m_new); p1[i] = __builtin_amdgcn_exp2f(p1[i] - m_new); ls += p0[i] + p1[i]; }
            if (__any(m_new > m_run)) {
                const float alpha = __builtin_amdgcn_exp2f(m_run - m_new);
                l_run *= alpha;
#pragma unroll
                for (int i = 0; i < 16; ++i) { o0[i] *= alpha; o1[i] *= alpha; }
            }
            l_run += ls; m_run = m_new;
            bf16x8 pb[4];
#pragma unroll
            for (int s = 0; s < 4; ++s) { u32x4 wv;
#pragma unroll
                for (int jj = 0; jj < 4; ++jj) wv[jj] = (s < 2) ? pk2(p0[8 * (s & 1) + 2 * jj], p0[8 * (s & 1) + 2 * jj + 1]) : pk2(p1[8 * (s & 1) + 2 * jj], p1[8 * (s & 1) + 2 * jj + 1]);
                pb[s] = __builtin_bit_cast(bf16x8, wv); }
            const LAS unsigned char* vb = lds + VOFF + buf * VBUF + (4 * hh + ((r & 15) >> 2)) * VP + (16 * (r >> 4) + 4 * (r & 3)) * 2;
#pragma unroll
            for (int s = 0; s < 4; ++s) {
                const v4i16_t lo0 = __builtin_amdgcn_ds_read_tr16_b64_v4i16((LAS v4i16_t*)(vb + s * 16 * VP)), hi0 = __builtin_amdgcn_ds_read_tr16_b64_v4i16((LAS v4i16_t*)(vb + s * 16 * VP + 8 * VP));
                const v4i16_t lo1 = __builtin_amdgcn_ds_read_tr16_b64_v4i16((LAS v4i16_t*)(vb + s * 16 * VP + 64)), hi1 = __builtin_amdgcn_ds_read_tr16_b64_v4i16((LAS v4i16_t*)(vb + s * 16 * VP + 8 * VP + 64));
                const bf16x8 a0 = (bf16x8){lo0[0], lo0[1], lo0[2], lo0[3], hi0[0], hi0[1], hi0[2], hi0[3]}, a1 = (bf16x8){lo1[0], lo1[1], lo1[2], lo1[3], hi1[0], hi1[1], hi1[2], hi1[3]};
                o0 = __builtin_amdgcn_mfma_f32_32x32x16_bf16(a0, pb[s], o0, 0, 0, 0);
                o1 = __builtin_amdgcn_mfma_f32_32x32x16_bf16(a1, pb[s], o1, 0, 0, 0);
            }
        }
        __syncthreads();
    }
#undef AT_LOAD
#undef AT_WRITE
    const float lt = l_run + __shfl_xor(l_run, 32), inv = 1.f / lt;
    bf16_t* op = O + qrow * 256 + h * 64 + 4 * hh;
#pragma unroll
    for (int g = 0; g < 4; ++g) {
        store4(op + 8 * g, (f32x4){o0[4 * g] * inv, o0[4 * g + 1] * inv, o0[4 * g + 2] * inv, o0[4 * g + 3] * inv});
        store4(op + 32 + 8 * g, (f32x4){o1[4 * g] * inv, o1[4 * g + 1] * inv, o1[4 * g + 2] * inv, o1[4 * g + 3] * inv});
    }
}

__device__ __forceinline__ void s5_lambar(const float* lam_re, const float* lam_im, float st, int idx, float& lr, float& li, float& br, float& bi) {
    lr = lam_re[idx]; li = lam_im[idx];
    const float er = __expf(lr * st); float s, c; sincos_acc(li * st, s, c); br = er * c; bi = er * s;
}
__device__ __forceinline__ void s5_unit(LAS unsigned char* lds, const Params& P, int l, int b, int g, const bf16_t* ub, bf16_t* y2) {
    const int tid = tid_opaque(), w = tid >> 6, lane = tid & 63, c15 = lane & 15, kq = lane >> 4;
    LAS float* BUs = (LAS float*)(lds + w * 14592);
    LAS unsigned char* Xs = lds + w * 14592 + 10240;
    LAS float* xe = (LAS float*)(lds + 8 * 14592);
    const float* lam_re = (const float*)PIN(13) + (l * 16 + g) * 64; const float* lam_im = (const float*)PIN(14) + (l * 16 + g) * 64;
    const float* b_re = (const float*)PIN(15) + (size_t)(l * 16 + g) * 64 * 16; const float* b_im = (const float*)PIN(16) + (size_t)(l * 16 + g) * 64 * 16;
    const float* c_re = (const float*)PIN(17) + (size_t)(l * 16 + g) * 16 * 64; const float* c_im = (const float*)PIN(18) + (size_t)(l * 16 + g) * 16 * 64;
    const f32x4 dh4 = *(const f32x4*)((const float*)PIN(19) + (l * 16 + g) * 16 + 4 * kq);
    const float st = __expf(((const float*)PIN(20))[l * 16 + g]);
    float lr_, li_, lbr, lbi; s5_lambar(lam_re, lam_im, st, lane, lr_, li_, lbr, lbi);
    bf16x8 bfr[8];
#pragma unroll
    for (int q = 0; q < 4; ++q) {
        const int pp = 16 * q + c15; float lr, li, br, bi; s5_lambar(lam_re, lam_im, st, pp, lr, li, br, bi);
        const float nr = br - 1.f, ni = bi, den = 1.f / (lr * lr + li * li);
        const float cfr = (nr * lr + ni * li) * den, cfi = (ni * lr - nr * li) * den;
        u32x4 wre = (u32x4){0, 0, 0, 0}, wim = wre;
        if (kq < 2) {
            float vr[8], vi[8];
#pragma unroll
            for (int j = 0; j < 8; ++j) { const float xr = b_re[pp * 16 + 8 * kq + j], xi = b_im[pp * 16 + 8 * kq + j]; vr[j] = cfr * xr - cfi * xi; vi[j] = cfr * xi + cfi * xr; }
#pragma unroll
            for (int j = 0; j < 4; ++j) { wre[j] = pk2(vr[2 * j], vr[2 * j + 1]); wim[j] = pk2(vi[2 * j], vi[2 * j + 1]); }
        }
        bfr[q] = __builtin_bit_cast(bf16x8, wre); bfr[q + 4] = __builtin_bit_cast(bf16x8, wim);
    }
    bf16x8 cfrg[4];
#pragma unroll
    for (int ks = 0; ks < 4; ++ks) { u32x4 wv;
#pragma unroll
        for (int j = 0; j < 4; ++j) { const int pp = 16 * ks + 4 * kq + j; wv[j] = pk2(c_re[c15 * 64 + pp], -c_im[c15 * 64 + pp]); }
        cfrg[ks] = __builtin_bit_cast(bf16x8, wv); }
    float Lr = lbr, Li = lbi;
#pragma unroll
    for (int i = 0; i < 8; ++i) { const float t = Lr * Lr - Li * Li; Li = 2.f * Lr * Li; Lr = t; }
    const long row0 = (long)b * SEQ + w * 256;
    float xr = 0.f, xi = 0.f;
    for (int pass = 0; pass < 2; ++pass) {
        u32x4 uw_n = (u32x4){0, 0, 0, 0};
        if (kq < 2) uw_n = *(const u32x4*)(ub + (row0 + c15) * 256 + g * 16 + 8 * kq);
        u32x2 uu_n = (u32x2){0u, 0u};
        if (pass) uu_n = *(const u32x2*)(ub + (row0 + c15) * 256 + g * 16 + 4 * kq);
#pragma unroll 1
        for (int sc = 0; sc < 16; ++sc) {
            const u32x4 uw = uw_n; const u32x2 uu_c = uu_n;
            if (sc < 15) {
                if (kq < 2) uw_n = *(const u32x4*)(ub + (row0 + 16 * (sc + 1) + c15) * 256 + g * 16 + 8 * kq);
                if (pass) uu_n = *(const u32x2*)(ub + (row0 + 16 * (sc + 1) + c15) * 256 + g * 16 + 4 * kq);
            }
            const bf16x8 uf = __builtin_bit_cast(bf16x8, uw);
#pragma unroll
            for (int nb = 0; nb < 8; ++nb) {
                const f32x4 d = __builtin_amdgcn_mfma_f32_16x16x32_bf16(uf, bfr[nb], (f32x4){0.f, 0.f, 0.f, 0.f}, 0, 0, 0);
                *(LAS f32x4*)(BUs + (16 * nb + c15) * 20 + 4 * kq) = d;
            }
            asm volatile("s_waitcnt lgkmcnt(0)" ::: "memory");
            f32x4 bre4[4], bim4[4];
#pragma unroll
            for (int q = 0; q < 4; ++q) { bre4[q] = *(const LAS f32x4*)(BUs + lane * 20 + 4 * q); bim4[q] = *(const LAS f32x4*)(BUs + (64 + lane) * 20 + 4 * q); }
#pragma unroll
            for (int tt = 0; tt < 16; ++tt) {
                const float bre = bre4[tt >> 2][tt & 3], bim = bim4[tt >> 2][tt & 3];
                const float nxr = lbr * xr - lbi * xi + bre, nxi = lbr * xi + lbi * xr + bim; xr = nxr; xi = nxi;
                if (pass) *(LAS unsigned*)(Xs + tt * 272 + lane * 4) = pk2(xr, xi);
            }
            asm volatile("s_waitcnt lgkmcnt(0)" ::: "memory");
            if (pass) {
                f32x4 ya = (f32x4){0.f, 0.f, 0.f, 0.f};
#pragma unroll
                for (int ks = 0; ks < 4; ++ks) { const bf16x8 a = *(const LAS bf16x8*)(Xs + c15 * 272 + (32 * ks + 8 * kq) * 2); ya = __builtin_amdgcn_mfma_f32_16x16x32_bf16(cfrg[ks], a, ya, 0, 0, 0); }
{ const long row = row0 + 16 * sc + c15; f32x4 o;
                  const f32x4 uu = (f32x4){__uint_as_float(uu_c.x << 16), __uint_as_float(uu_c.x & 0xffff0000u), __uint_as_float(uu_c.y << 16), __uint_as_float(uu_c.y & 0xffff0000u)};
#pragma unroll
                  for (int e = 0; e < 4; ++e) { const float y = ya[e] + dh4[e] * uu[e]; const float z = 0.7978845608028654f * (y + 0.044715f * y * y * y);
                      const float th = 1.f - 2.f * __builtin_amdgcn_rcpf(1.f + __builtin_amdgcn_exp2f(2.f * LOG2E * z)); o[e] = 0.5f * y * (1.f + th); }
                  store4(y2 + row * 256 + g * 16 + 4 * kq, o); }
                asm volatile("s_waitcnt lgkmcnt(0)" ::: "memory");
            }
        }
        if (pass == 0) {
            xe[(w * 64 + lane) * 2] = xr; xe[(w * 64 + lane) * 2 + 1] = xi;
            __syncthreads();
            float cr = 0.f, ci = 0.f;
            for (int w2 = 0; w2 < w; ++w2) { const float er = xe[(w2 * 64 + lane) * 2], ei = xe[(w2 * 64 + lane) * 2 + 1]; const float t = Lr * cr - Li * ci + er; ci = Lr * ci + Li * cr + ei; cr = t; }
            xr = cr; xi = ci;
        }
    }
    __syncthreads();
}

enum { CM_NAT = 0, CM_IN1, CM_IN2, CM_UQ, CM_UKV, CM_UP, CM_NATP };
__device__ __forceinline__ int perm32(int rho) { return 8 * ((rho & 15) >> 2) + 4 * (rho >> 4) + (rho & 3); }
__device__ __forceinline__ int colmap(int type, int n) {
    switch (type) {
    case CM_IN1: {
        if (n < 384) return (n & ~31) + perm32(n & 31);
        if (n < 416) return 640 + (n - 384);
        if (n < 420) return 1440 + (n - 416);
        if (n < 512) return -1;
        if (n < 768) { const int q = n - 512; return 384 + (q & ~31) + perm32(q & 31); }
        if (n < 1280) { const int t = (n - 768) / 256, p = (n - 768) % 256, bj = p / 128, wc = (p % 128) / 32, j = p % 32; return (t == 0 ? 672 : 928) + wc * 64 + 32 * bj + perm32(j); }
        if (n < 1536) { const int q = n - 1280; return 1184 + (q & ~31) + perm32(q & 31); }
        { const int q = n - 1536; return 1444 + (q & ~31) + perm32(q & 31); } }
    case CM_IN2: return 1700 + (n & ~31) + perm32(n & 31);
    case CM_UQ: { if (n < 256) { const int bj = n / 128, wc = (n % 128) / 32, j = n % 32; return wc * 96 + 32 * bj + perm32(j); } const int p = n - 256; if (p < 128) return (p / 32) * 96 + 64 + (p % 32); return -1; }
    case CM_UKV: { if (n < 256) { const int bj = n / 128, wc = (n % 128) / 32, j = n % 32; return wc * 128 + 32 * bj + perm32(j); } const int q0 = n - 256, q = (q0 & ~31) + perm32(q0 & 31); return (q / 64) * 128 + 64 + (q % 64); }
    case CM_UP: { const int pn = n / 256, q = n % 256, bj = q / 128, qq = q % 128; return bj * DFF + pn * 128 + (qq & ~31) + perm32(qq & 31); }
    case CM_NATP: return (n & ~31) + perm32(n & 31);
    default: return n;
    }
}
struct WEnt { const float* src; const float* gain; bf16_t* dst; int src_ld, K, Np, cm; };
__device__ __forceinline__ void wconv_item(LAS float* scr, const WEnt& e, int item, int lane) {
    const int nblk = e.Np / 32, kb = item / nblk, nb = item % nblk, k0 = 64 * kb, n0 = 32 * nb;
    const int col = colmap(e.cm, n0 + (lane & 31));
    const float* sp = e.src + (size_t)(k0 + (lane >> 5)) * e.src_ld + (col >= 0 ? col : 0);
    const float* gp = e.gain ? e.gain + k0 + (lane >> 5) : nullptr;
    float vv[32];
#pragma unroll
    for (int i = 0; i < 32; ++i) vv[i] = sp[(size_t)(2 * i) * e.src_ld];
#pragma unroll
    for (int i = 0; i < 32; ++i) { float v = vv[i]; if (gp) v *= gp[2 * i]; scr[(2 * i + (lane >> 5)) * 33 + (lane & 31)] = (col >= 0) ? v : 0.f; }
    asm volatile("s_waitcnt lgkmcnt(0)" ::: "memory");
    const int c = lane & 7;
#pragma unroll
    for (int j = 0; j < 4; ++j) { const int n = (lane >> 3) + 8 * j; const LAS float* sq = scr + (8 * c) * 33 + n;
        u32x4 o; o.x = pk2(sq[0 * 33], sq[1 * 33]); o.y = pk2(sq[2 * 33], sq[3 * 33]); o.z = pk2(sq[4 * 33], sq[5 * 33]); o.w = pk2(sq[6 * 33], sq[7 * 33]);
        *(u32x4*)(e.dst + (size_t)(n0 + n) * e.K + k0 + 8 * c) = o; }
    asm volatile("s_waitcnt lgkmcnt(0)" ::: "memory");
}
__device__ __forceinline__ void phase_weights(LAS unsigned char* lds, const Params& P, int l) {
    unsigned char* wsl = launder_ws(P.ws);
    bf16_t* W = (bf16_t*)(wsl + WS_W);
    const float* w_in = (const float*)PIN(3) + (size_t)l * DM * DIN;
    const float* an_g = (const float*)PIN(2) + l * DM;
    const int tid = tid_opaque(), w = tid >> 6, lane = tid & 63;
    LAS float* scr = (LAS float*)(lds + w * 8448);
    const int gw = blockIdx.x * 8 + w, NGW = gridDim.x * 8;
    constexpr int I0 = 16 * 56, I1 = 16 * 96, I2 = 6 * 16, I3 = 4 * 16, I4 = 4 * 8, I5 = 4 * 32, I8 = 16 * 32, I9 = 16 * 176, I10 = 44 * 32;
    constexpr int C0 = I0, C1 = C0 + I1, C2 = C1 + I2, C3 = C2 + I3, C4 = C3 + I4, C5 = C4 + I5, C6 = C5 + I5, C7 = C6 + I5, C8 = C7 + I8, C9 = C8 + I9, C10 = C9 + I10;
    for (int it = gw; it < C10; it += NGW) {
        WEnt e; int r;
        if (it < C0) { r = it; e = WEnt{w_in, an_g, W + WO_IN1 / 2, DIN, 1024, 1792, CM_IN1}; }
        else if (it < C1) { r = it - C0; e = WEnt{w_in, an_g, W + WO_IN2 / 2, DIN, 1024, 3072, CM_IN2}; }
        else if (it < C2) { r = it - C1; e = WEnt{(const float*)PIN(5) + (size_t)l * 384 * 384, (const float*)PIN(4) + l * 384, W + WO_UQ / 2, 384, 384, 512, CM_UQ}; }
        else if (it < C3) { r = it - C2; e = WEnt{(const float*)PIN(7) + (size_t)l * 256 * 512, (const float*)PIN(6) + l * 256, W + WO_UKV / 2, 512, 256, 512, CM_UKV}; }
        else if (it < C4) { r = it - C3; e = WEnt{(const float*)PIN(21) + (size_t)l * 256 * 256, nullptr, W + WO_GLU / 2, 256, 256, 256, CM_NATP}; }
        else if (it < C7) { const int z = (it - C4) / I5; r = (it - C4) % I5; e = WEnt{(const float*)PIN(23) + ((size_t)l * 3 + z) * 256 * 1024, nullptr, W + WO_B / 2 + (size_t)z * 1024 * 256, 1024, 256, 1024, CM_NATP}; }
        else if (it < C8) { r = it - C7; e = WEnt{(const float*)PIN(24) + (size_t)l * 1024 * 1024, nullptr, W + WO_OUT / 2, 1024, 1024, 1024, CM_NATP}; }
        else if (it < C9) { r = it - C8; e = WEnt{(const float*)PIN(26) + (size_t)l * 1024 * 5632, (const float*)PIN(25) + l * DM, W + WO_UP / 2, 5632, 1024, 5632, CM_UP}; }
        else { r = it - C9; e = WEnt{(const float*)PIN(28) + (size_t)l * DFF * 1024, nullptr, W + WO_DN / 2, 1024, DFF, 1024, CM_NATP}; }
        wconv_item(scr, e, r, lane);
    }
}
__device__ __forceinline__ void phase_prologue(const Params& P) {
    const float INVF[16] = {1.0f, 0.5623413324356079f, 0.3162277638912201f, 0.17782793939113617f, 0.10000000149011612f, 0.05623413249850273f, 0.03162277489900589f, 0.017782794311642647f,
                            0.009999999776482582f, 0.005623413249850273f, 0.003162277629598975f, 0.0017782794311642647f, 0.0010000000474974513f, 0.000562341301701963f, 0.0003162277571391314f, 0.00017782794020604342f};
    const int tid = tid_opaque(), w = tid >> 6, lane = tid & 63;
    const float* x = (const float*)PIN(0); const int* pos = (const int*)PIN(1);
    unsigned char* wsl = launder_ws(P.ws);
    bf16_t* xb = (bf16_t*)(wsl + WS_XB); float* sm = (float*)(wsl + WS_SM);
    float* ssqx = sm + SM_SSQX / 4; float* cosT = sm + SM_COS / 4; float* sinT = sm + SM_SIN / 4;
    float invf = 0.f;
#pragma unroll
    for (int i = 0; i < 16; ++i) if ((lane & 15) == i) invf = INVF[i];
    for (long row0 = ((long)blockIdx.x * 8 + w) * 4; row0 < MTOK; row0 += (long)gridDim.x * 32) {
        f32x4 v[4][4];
#pragma unroll
        for (int q = 0; q < 4; ++q)
#pragma unroll
            for (int j = 0; j < 4; ++j) v[q][j] = *(const f32x4*)(x + (row0 + q) * 1024 + j * 256 + lane * 4);
#pragma unroll
        for (int q = 0; q < 4; ++q) {
            const long row = row0 + q; float ss = 0.f;
#pragma unroll
            for (int j = 0; j < 4; ++j) { store4(xb + row * 1024 + j * 256 + lane * 4, v[q][j]); ss += dot4(v[q][j]); }
#pragma unroll
            for (int o = 1; o < 64; o <<= 1) ss += __shfl_xor(ss, o);
            if (lane < 16) { ssqx[row * 16 + lane] = (lane == 0) ? ss : 0.f;
                const float ang = (float)pos[row] * invf; float sn, cs; sincos_acc(ang, sn, cs); cosT[row * 16 + lane] = cs; sinT[row * 16 + lane] = sn; }
        }
    }
}

#define XB_TMO      128
#define XB_XCNT(j)  (256  + 64 * (j))
#define XB_XSUB(j)  (1280 + 64 * (j))
#define XB_XGEN(j)  (2304 + 64 * (j))
#define XB_TOP      3328
#define XB_TOPGEN   3392
#define XCD_BAR_WORDS 3456
#define XB_SPIN_CAP (1u << 18)
__device__ __forceinline__ unsigned xb_ld(unsigned* p)              { return __hip_atomic_load(p, __ATOMIC_RELAXED, __HIP_MEMORY_SCOPE_AGENT); }
__device__ __forceinline__ unsigned xb_add(unsigned* p, unsigned v) { return __hip_atomic_fetch_add(p, v, __ATOMIC_RELAXED, __HIP_MEMORY_SCOPE_AGENT); }
__device__ __forceinline__ unsigned xb_xcc_id() { return (unsigned)__builtin_amdgcn_s_getreg((3 << 11) | 20) & 0xFu; }
#define XB_SPIN(cond, bar) do { unsigned _sp = 0; while (cond) { __builtin_amdgcn_s_sleep(1); \
    if ((++_sp & 255u) == 0u) { if (xb_ld(&(bar)[XB_TMO])) break; if (_sp > XB_SPIN_CAP) { atomicAdd(&(bar)[XB_TMO], 1u); break; } } } } while (0)
struct XcdBarrier { unsigned* bar; unsigned x; volatile LAS unsigned* st; };
__device__ __forceinline__ XcdBarrier xcd_barrier_post(unsigned* bar, volatile LAS unsigned* st) {
    XcdBarrier b; b.bar = bar; b.x = xb_xcc_id(); b.st = st;
    if (tid_opaque() == 0) (void)xb_add(&bar[XB_XCNT(b.x)], 1u);
    return b;
}
__device__ __forceinline__ void xcd_barrier_complete(unsigned* bar, unsigned x, unsigned& nloc, unsigned& nx) {
    const unsigned G = gridDim.x * gridDim.y * gridDim.z;
    unsigned sum, cnt, mine, sp = 0u;
    for (;;) {
        sum = 0u; cnt = 0u; mine = 0u;
#pragma unroll
        for (unsigned j = 0; j < 16; ++j) { const unsigned c = xb_ld(&bar[XB_XCNT(j)]); sum += c; cnt += (c > 0u) ? 1u : 0u; mine = (j == x) ? c : mine; }
        if (sum == G) break;
        __builtin_amdgcn_s_sleep(1);
        if ((++sp & 255u) == 0u) { if (xb_ld(&bar[XB_TMO])) break; if (sp > XB_SPIN_CAP) { atomicAdd(&bar[XB_TMO], 1u); break; } }
    }
    nloc = mine > 0u ? mine : 1u; nx = cnt > 0u ? cnt : 1u;
}
__device__ __forceinline__ void xcd_barrier(const XcdBarrier& b) {
    asm volatile("s_waitcnt vmcnt(0)" ::: "memory");
    __syncthreads();
    if (tid_opaque() == 0) {
        unsigned* bar = b.bar;
        __builtin_amdgcn_s_waitcnt(0);
        unsigned nloc = b.st[0], nx = b.st[1];
        if (nloc == 0u) { xcd_barrier_complete(bar, b.x, nloc, nx); b.st[0] = nloc; b.st[1] = nx; }
        const unsigned old = xb_add(&bar[XB_XSUB(b.x)], 1u);
        const unsigned gen = old / nloc;
        if (old + 1u == (gen + 1u) * nloc) {
            __builtin_amdgcn_fence(__ATOMIC_RELEASE, "agent");
            asm volatile("s_waitcnt vmcnt(0)" ::: "memory");
            const unsigned og = xb_add(&bar[XB_TOP], 1u);
            const unsigned tg = og / nx;
            if (og + 1u == (tg + 1u) * nx) xb_add(&bar[XB_TOPGEN], 1u);
            else XB_SPIN(xb_ld(&bar[XB_TOPGEN]) == tg, bar);
            __builtin_amdgcn_fence(__ATOMIC_ACQUIRE, "agent");
            xb_add(&bar[XB_XGEN(b.x)], 1u);
            asm volatile("s_waitcnt vmcnt(0)" ::: "memory");
        } else {
            XB_SPIN(xb_ld(&bar[XB_XGEN(b.x)]) == gen, bar);
            __builtin_amdgcn_fence(__ATOMIC_ACQUIRE, "agent");
            asm volatile("s_waitcnt vmcnt(0)" ::: "memory");
        }
    }
    __syncthreads();
}

__global__ void __launch_bounds__(512, 2) mega(Params P, int ph_lo, int ph_hi) {
    extern __shared__ __attribute__((aligned(16))) unsigned char lds_raw[];
    LAS unsigned char* lds = (LAS unsigned char*)lds_raw;
    cg::grid_group grid = cg::this_grid();
    volatile LAS unsigned* bst = (volatile LAS unsigned*)(lds + LDS_XOFF + 8192);
    { const int t4 = tid_opaque(); if (t4 < 4) bst[t4] = 0u; }
    __syncthreads();
    XcdBarrier bar; bar.bar = (unsigned*)P.ws; bar.x = 0; bar.st = bst;
    if (ph_hi - ph_lo > 1) bar = xcd_barrier_post((unsigned*)P.ws, bst);
    for (int ph = ph_lo; ph < ph_hi; ++ph) {
    int G = gridDim.x, c = blockIdx.x; asm volatile("" : "+s"(G), "+s"(c));
    unsigned char* ws = launder_ws(P.ws);
    float* outp = (float*)launder_ws((unsigned char*)P.out);
    bf16_t* W = (bf16_t*)(ws + WS_W);
    bf16_t* xb = (bf16_t*)(ws + WS_XB);
    float* sm = (float*)(ws + WS_SM);
    float *ssqx = sm + SM_SSQX / 4, *ssq_cq = sm + SM_SSQCQ / 4, *ssq_ckv = sm + SM_SSQCKV / 4, *kr_rot = sm + SM_KRROT / 4, *ssq_kr = sm + SM_SSQKR / 4, *logf_ = sm + SM_LOGF / 4,
          *cl = sm + SM_CL / 4, *ssq_qn = sm + SM_SSQQN / 4, *ssq_qr = sm + SM_SSQQR / 4, *cosT = sm + SM_COS / 4, *sinT = sm + SM_SIN / 4;
    bf16_t* obr = (bf16_t*)(ws + WS_OBR);
    unsigned char* X = ws + WS_X;
    bf16_t *cq = (bf16_t*)(X + XA_CQ), *ckv = (bf16_t*)(X + XA_CKV), *ub = (bf16_t*)(X + XA_U), *qf = (bf16_t*)(X + XA_QF), *kf = (bf16_t*)(X + XA_KF), *vf = (bf16_t*)(X + XA_VF),
           *y2 = (bf16_t*)(X + XA_Y2), *qm = (bf16_t*)(X + XA_QM), *km = (bf16_t*)(X + XA_KM), *vm = (bf16_t*)(X + XA_VM);
    bf16_t *gates = (bf16_t*)(X + XB_GATES), *merged = (bf16_t*)(X + XB_MERGED), *act = (bf16_t*)(X + XC_ACT);
        const int l = ph / NPHASE_PER_LAYER, k = ph % NPHASE_PER_LAYER;
        {
        if (k == 0 && PHON(0)) {
            phase_weights(lds, P, l);
            if (l == 0) phase_prologue(P);
        } else if (k == 1 && PHON(1)) {
            pg8::Gemm g{xb, W + WO_IN1 / 2, 1024, 1024, 1024, 0, 0, 0}; pg8::Sched S; S.init(MTOK / 256, 7, G, c, 1, 0);
            EpiIn1 E{ssqx, cq, ckv, qf, kf, vf, ub, ssq_cq, ssq_ckv, ssq_kr, kr_rot, logf_, cosT, sinT, (const float*)PIN(9) + l * 96, (const float*)PIN(10) + l * 64, (const float*)PIN(11) + l * 64, (const float*)PIN(12) + l * 4};
            pg8::gemm_phase(lds, g, S, E);
        } else if (k == 2 && PHON(2)) {
            for (int q = c; q < 256; q += G) s5_unit(lds, P, l, q >> 4, q & 15, ub, y2);
        } else if (k == 3 && PHON(3)) {
            { pg8::Gemm g{cq, W + WO_UQ / 2, 384, 384, 384, 0, 0, 0}; pg8::Sched S; S.init(MTOK / 256, 2, G, c, 1, 0);
              EpiUq E{ssq_cq, qm, ssq_qn, ssq_qr, cosT, sinT, (const float*)PIN(8) + l * 96}; pg8::gemm_phase(lds, g, S, E); }
            { pg8::Gemm g{ckv, W + WO_UKV / 2, 256, 256, 256, 0, 0, 0}; pg8::Sched S; S.init(MTOK / 256, 2, G, c, 1, 0);
              EpiUkv E{ssq_ckv, ssq_kr, kr_rot, (const float*)PIN(9) + l * 96, km, vm}; pg8::gemm_phase(lds, g, S, E); }
            { pg8::Gemm g{y2, W + WO_GLU / 2, 256, 256, 256, 0, 0, 0}; pg8::Sched S; S.init(MTOK / 256, 1, G, c, 1, 0);
              EpiGlu E{y2, (const float*)PIN(22) + l * 256, obr + (size_t)2 * MTOK * 256}; pg8::gemm_phase(lds, g, S, E); }
            { const int cs = (G >= 192) ? (c >= 128 ? c - 128 : c + (G - 128)) : c;
            for (int q = cs; q < 64; q += G) {
                if (tid_opaque() < 64) { const int lane = tid_opaque() & 63, b = q >> 2, h = q & 3; const long base = ((long)b * SEQ + 32 * lane) * 4 + h;
                    float tot = 0.f;
                    for (int i = 0; i < 32; ++i) tot += logf_[base + 4 * i];
                    float inc = tot;
#pragma unroll
                    for (int o = 1; o < 64; o <<= 1) { const float t = __shfl_up(inc, o); if (lane >= o) inc += t; }
                    float run = inc - tot;
                    for (int i = 0; i < 32; ++i) { run += logf_[base + 4 * i]; cl[base + 4 * i] = run * LOG2E; } }
            }
            }
        } else if (k == 4 && PHON(4)) {
            for (int idx = c; idx < 256; idx += G) {
                const int b = idx >> 4, h = (idx >> 2) & 3, pr = idx & 3;
                attn_unit<true>(lds, qm, km, vm, obr, ssq_qn, ssq_qr, cl, b, h, 7 - pr);
                attn_unit<false>(lds, qf, kf, vf, obr + (size_t)MTOK * 256, ssq_qn, ssq_qr, cl, b, h, 7 - pr);
                attn_unit<true>(lds, qm, km, vm, obr, ssq_qn, ssq_qr, cl, b, h, pr);
                attn_unit<false>(lds, qf, kf, vf, obr + (size_t)MTOK * 256, ssq_qn, ssq_qr, cl, b, h, pr);
            }
        } else if (k == 5 && PHON(5)) {
            pg8::Gemm g{xb, W + WO_IN2 / 2, 1024, 1024, 1024, 0, 0, PROBE_KREP == 5 ? 2 : 0}; pg8::Sched S; S.init(MTOK / 256, 12, G, c, 1, 0);
            EpiGates E{ssqx, gates}; pg8::gemm_phase(lds, g, S, E);
        } else if (k == 6 && PHON(6)) {
            pg8::Gemm g{obr, W + WO_B / 2, 256, 256, 256, (long)MTOK * 256, 1024L * 256, 0}; pg8::Sched S; S.init(MTOK / 256, 4, G, c, 3, 0);
            EpiWb E{gates, merged}; pg8::gemm_phase(lds, g, S, E);
        } else if (k == 7 && PHON(7)) {
            pg8::Gemm g{merged, W + WO_OUT / 2, 1024, 1024, 1024, 0, 0, 0}; pg8::Sched S; S.init(MTOK / 256, 4, G, c, 1, 0);
            EpiRes E{l == 0 ? (const float*)PIN(0) : (const float*)nullptr, nullptr, xb, ssqx}; pg8::gemm_phase(lds, g, S, E);
        } else if (k == 8 && PHON(8)) {
            pg8::Gemm g{xb, W + WO_UP / 2, 1024, 1024, 1024, 0, 0, PROBE_KREP == 8 ? 2 : 0}; pg8::Sched S; S.init(NB * 8 + 2, 22, G, c, 1, 1);
            EpiUp E{ssqx, (const float*)PIN(27) + (size_t)l * 3 * 5632, act}; pg8::gemm_phase(lds, g, S, E);
        } else if (PHON(9)) {
            pg8::Gemm g{act, W + WO_DN / 2, DFF, DFF, DFF, 0, 0, 0}; pg8::Sched S; S.init(MTOK / 256, 4, G, c, 1, 0);
            EpiRes E{nullptr, l == NLAYER - 1 ? outp : (float*)nullptr, xb, ssqx}; pg8::gemm_phase(lds, g, S, E);
        }
        }
        if (ph + 1 < ph_hi) { if (ph_lo < 0) grid.sync(); else xcd_barrier(bar); }
    }
}

extern "C" void kernel_launch(void* const* d_in, const int* in_sizes, int n_in, void* d_out, int out_size, void* d_ws, size_t ws_size, hipStream_t stream) {
    static int grid = 0;
    if (grid == 0) {
        if (n_in != 29 || in_sizes[0] != MTOK * DM || out_size != MTOK * DM || ws_size < WS_END) {
            fprintf(stderr, "kernel_launch: unexpected shapes / workspace (n_in %d, in0 %d, out %d, ws %zu, need %zu)\n", n_in, n_in > 0 ? in_sizes[0] : -1, out_size, ws_size, (size_t)WS_END); grid = -1; return; }
        int dev = 0, cus = 0, per_cu = 0;
        hipGetDevice(&dev); hipDeviceGetAttribute(&cus, hipDeviceAttributeMultiprocessorCount, dev);
        hipFuncSetAttribute((const void*)mega, hipFuncAttributeMaxDynamicSharedMemorySize, LDS_BYTES);
        hipOccupancyMaxActiveBlocksPerMultiprocessor(&per_cu, (const void*)mega, 512, LDS_BYTES);
        if (per_cu < 1) { fprintf(stderr, "kernel_launch: occupancy query says %d blocks per CU\n", per_cu); per_cu = 1; }
        (void)hipGetLastError();
        grid = cus * 1;
    }
    if (grid < 0) return;
    Params p{};
    for (int i = 0; i < 29; ++i) p.in[i] = d_in[i];
    p.out = (float*)d_out; p.ws = (unsigned char*)d_ws;
    if (hipMemsetAsync(d_ws, 0, 16384, stream) != hipSuccess) { fprintf(stderr, "memset failed\n"); return; }
#if MK_MULTI
    for (int ph = 0; ph < NPHASE; ++ph) hipLaunchKernelGGL(mega, dim3(grid), dim3(512), LDS_BYTES, stream, p, ph, ph + 1);
#else
    int lo = 0, hi = NPHASE;
    void* args[] = {&p, &lo, &hi};
    hipError_t e = hipLaunchCooperativeKernel((const void*)mega, dim3(grid), dim3(512), args, LDS_BYTES, stream);
    if (e != hipSuccess) fprintf(stderr, "cooperative launch failed: %s (grid %d)\n", hipGetErrorString(e), grid);
#endif
}
```

```cpp
#include <hip/hip_runtime.h>
#include <hip/hip_cooperative_groups.h>
#include <cstdio>
#include <cstdint>
namespace cg = cooperative_groups;

#ifndef MK_MULTI
#define MK_MULTI 0
#endif

#ifndef PROBE_K
#define PROBE_K -1
#endif
#ifndef PROBE_KREP
#define PROBE_KREP -1
#endif
#ifndef PHSEL
#define PHSEL -1
#endif
#define PHON(x) (PHSEL < 0 || PHSEL == (x))
#define LAS __attribute__((address_space(3)))
typedef unsigned short bf16_t;
typedef short bf16x8 __attribute__((ext_vector_type(8)));
typedef float f32x2 __attribute__((ext_vector_type(2)));
typedef float f32x4 __attribute__((ext_vector_type(4)));
typedef float f32x16 __attribute__((ext_vector_type(16)));
typedef unsigned u32x2 __attribute__((ext_vector_type(2)));
typedef unsigned u32x4 __attribute__((ext_vector_type(4)));
typedef __bf16 bf16x2_t __attribute__((ext_vector_type(2)));
typedef short v4i16_t __attribute__((ext_vector_type(4)));

constexpr int NB = 16, SEQ = 2048, MTOK = NB * SEQ, DM = 1024, DFF = 2816, DIN = 4772, NLAYER = 4;
constexpr float EPS = 1e-6f, LOG2E = 1.4426950408889634f;
constexpr int NPHASE_PER_LAYER = 10, NPHASE = NLAYER * NPHASE_PER_LAYER;
constexpr int LDS_BYTES = 147456;
constexpr int LDS_XOFF = 131072;

constexpr size_t MiB = 1024 * 1024;
constexpr size_t WS_W = 1 * MiB;
constexpr size_t WO_IN1 = 0, WO_IN2 = WO_IN1 + 1792ull * 1024 * 2, WO_UQ = WO_IN2 + 3072ull * 1024 * 2, WO_UKV = WO_UQ + 512ull * 384 * 2,
                 WO_GLU = WO_UKV + 512ull * 256 * 2, WO_B = WO_GLU + 256ull * 256 * 2, WO_OUT = WO_B + 3ull * 1024 * 256 * 2,
                 WO_UP = WO_OUT + 1024ull * 1024 * 2, WO_DN = WO_UP + 5632ull * 1024 * 2, WO_END = WO_DN + 1024ull * 2816 * 2;
static_assert(WO_END <= 32 * MiB, "weights");
constexpr size_t WS_XB = WS_W + 32 * MiB + 1 * MiB;
constexpr size_t WS_SM = WS_XB + 64 * MiB + 1 * MiB;
constexpr size_t SM_SSQX = 0, SM_SSQCQ = SM_SSQX + (size_t)MTOK * 16 * 4, SM_SSQCKV = SM_SSQCQ + (size_t)MTOK * 8 * 4, SM_KRROT = SM_SSQCKV + (size_t)MTOK * 4 * 4,
                 SM_SSQKR = SM_KRROT + (size_t)MTOK * 32 * 4, SM_LOGF = SM_SSQKR + (size_t)MTOK * 4, SM_CL = SM_LOGF + (size_t)MTOK * 4 * 4, SM_SSQQN = SM_CL + (size_t)MTOK * 4 * 4,
                 SM_SSQQR = SM_SSQQN + (size_t)MTOK * 4 * 4, SM_COS = SM_SSQQR + (size_t)MTOK * 4 * 4, SM_SIN = SM_COS + (size_t)MTOK * 16 * 4, SM_END = SM_SIN + (size_t)MTOK * 16 * 4;
constexpr size_t WS_OBR = WS_SM + 16 * MiB;
static_assert(SM_END <= 16 * MiB, "small");
constexpr size_t WS_X = WS_OBR + 48 * MiB;
constexpr size_t XA_CQ = 0, XA_CKV = XA_CQ + (size_t)MTOK * 384 * 2, XA_U = XA_CKV + (size_t)MTOK * 256 * 2, XA_QF = XA_U + (size_t)MTOK * 256 * 2, XA_KF = XA_QF + (size_t)MTOK * 256 * 2,
                 XA_VF = XA_KF + (size_t)MTOK * 256 * 2, XA_Y2 = XA_VF + (size_t)MTOK * 256 * 2, XA_QM = XA_Y2 + (size_t)MTOK * 256 * 2, XA_KM = XA_QM + (size_t)MTOK * 384 * 2,
                 XA_VM = XA_KM + (size_t)MTOK * 384 * 2, XA_END = XA_VM + (size_t)MTOK * 256 * 2;
constexpr size_t XB_GATES = 0, XB_MERGED = XB_GATES + (size_t)MTOK * 3072 * 2, XB_END = XB_MERGED + (size_t)MTOK * 1024 * 2;
constexpr size_t XC_ACT = 0, XC_END = (size_t)MTOK * DFF * 2;
constexpr size_t X_BYTES = XB_END > XA_END ? (XB_END > XC_END ? XB_END : XC_END) : (XA_END > XC_END ? XA_END : XC_END);
constexpr size_t WS_END = WS_X + X_BYTES;

struct Params {
    const void* in[29];
    float* out;
    unsigned char* ws;
};

typedef __attribute__((address_space(1))) unsigned char g_u8;
__device__ __forceinline__ const void* launder_ptr(const void* p) { const g_u8* q = (const g_u8*)p; asm volatile("" : "+s"(q)); return (const void*)q; }
__device__ __forceinline__ unsigned char* launder_ws(unsigned char* p) { g_u8* q = (g_u8*)p; asm volatile("" : "+s"(q)); return (unsigned char*)q; }
#define PIN(i) launder_ptr(P.in[i])
__device__ __forceinline__ int tid_opaque() { int t = threadIdx.x; asm volatile("" : "+v"(t)); return t; }
__device__ __forceinline__ unsigned pk2(float lo, float hi) { f32x2 v = {lo, hi}; bf16x2_t b = __builtin_convertvector(v, bf16x2_t); return __builtin_bit_cast(unsigned, b); }
__device__ __forceinline__ float bf2f(unsigned short b) { return __uint_as_float(((unsigned)b) << 16); }
__device__ __forceinline__ unsigned short f2bf(float f) { return (unsigned short)(pk2(f, 0.f) & 0xffffu); }
__device__ __forceinline__ void store4(bf16_t* p, f32x4 v) { u32x2 w; w.x = pk2(v.x, v.y); w.y = pk2(v.z, v.w); *(u32x2*)p = w; }
__device__ __forceinline__ void store8(bf16_t* p, f32x4 a, f32x4 b) { u32x4 w; w.x = pk2(a.x, a.y); w.y = pk2(a.z, a.w); w.z = pk2(b.x, b.y); w.w = pk2(b.z, b.w); *(u32x4*)p = w; }
__device__ __forceinline__ f32x4 load4bf(const bf16_t* p) { u32x2 w = *(const u32x2*)p; f32x4 r; r.x = __uint_as_float(w.x << 16); r.y = __uint_as_float(w.x & 0xffff0000u); r.z = __uint_as_float(w.y << 16); r.w = __uint_as_float(w.y & 0xffff0000u); return r; }
__device__ __forceinline__ float sigmoidf_(float z) { return __builtin_amdgcn_rcpf(1.f + __builtin_amdgcn_exp2f(-z * LOG2E)); }
__device__ __forceinline__ float red_fq(float s) {
    const unsigned u = __float_as_uint(s);
    auto a = __builtin_amdgcn_permlane16_swap(u, u, false, false);
    const float t = __uint_as_float(a[0]) + __uint_as_float(a[1]);
    const unsigned v = __float_as_uint(t);
    auto b = __builtin_amdgcn_permlane32_swap(v, v, false, false);
    return __uint_as_float(b[0]) + __uint_as_float(b[1]);
}
__device__ __forceinline__ float dot4(f32x4 a) { return (a.x * a.x + a.y * a.y) + (a.z * a.z + a.w * a.w); }
template <int NP> __device__ __forceinline__ float row_total(const float* base, long row, int fq) {
    float s;
    if (NP == 16) { f32x4 v = *(const f32x4*)(base + row * 16 + 4 * fq); s = (v.x + v.y) + (v.z + v.w); }
    else if (NP == 8) { f32x2 v = *(const f32x2*)(base + row * 8 + 2 * fq); s = v.x + v.y; }
    else { s = base[row * 4 + fq]; }
    return red_fq(s);
}

template <int NP> __device__ __forceinline__ void row_scales(float (&rs)[2][4], const float* base, long row0, int fq, float inv_n) {
    float t[2][4];
#pragma unroll
    for (int ai = 0; ai < 2; ++ai)
#pragma unroll
        for (int m = 0; m < 4; ++m) { const long row = row0 + ai * 128 + m * 16;
            if (NP == 16) { const f32x4 v = *(const f32x4*)(base + row * 16 + 4 * fq); t[ai][m] = (v.x + v.y) + (v.z + v.w); }
            else if (NP == 8) { const f32x2 v = *(const f32x2*)(base + row * 8 + 2 * fq); t[ai][m] = v.x + v.y; }
            else t[ai][m] = base[row * 4 + fq]; }
#pragma unroll
    for (int ai = 0; ai < 2; ++ai)
#pragma unroll
        for (int m = 0; m < 4; ++m) rs[ai][m] = rsqrtf(red_fq(t[ai][m]) * inv_n + EPS);
}
__device__ __forceinline__ void sincos_acc(float x, float& s, float& c) {
    const double xd = (double)x;
    const double kd = __builtin_rint(xd * 0.63661977236758134308);
    const double rd = xd - kd * 1.57079632679489661923;
    const int q = ((int)kd) & 3;
    const float y = (float)rd, y2 = y * y;
    const float sy = y + y * y2 * (-1.6666666667e-1f + y2 * (8.3333333333e-3f + y2 * (-1.9841269841e-4f + y2 * 2.7557319224e-6f)));
    const float cy = 1.f + y2 * (-0.5f + y2 * (4.1666666667e-2f + y2 * (-1.3888888889e-3f + y2 * (2.4801587302e-5f + y2 * -2.7557319224e-7f))));
    s = (q == 0) ? sy : (q == 1) ? cy : (q == 2) ? -sy : -cy;
    c = (q == 0) ? cy : (q == 1) ? -sy : (q == 2) ? -cy : sy;
}
__device__ __forceinline__ float max3f(float a, float b, float c) { float r; asm("v_max3_f32 %0, %1, %2, %3" : "=v"(r) : "v"(a), "v"(b), "v"(c)); return r; }
__device__ __forceinline__ float min2f(float a, float b) { float r; asm("v_min_f32_e32 %0, %1, %2" : "=v"(r) : "v"(a), "v"(b)); return r; }
__device__ __forceinline__ float max2f(float a, float b) { float r; asm("v_max_f32_e32 %0, %1, %2" : "=v"(r) : "v"(a), "v"(b)); return r; }
__device__ __forceinline__ float dpp_ror1(float v) { return __builtin_bit_cast(float, __builtin_amdgcn_mov_dpp(__builtin_bit_cast(int, v), 0x121, 0xf, 0xf, true)); }
__device__ __forceinline__ float dpp_ror2(float v) { return __builtin_bit_cast(float, __builtin_amdgcn_mov_dpp(__builtin_bit_cast(int, v), 0x122, 0xf, 0xf, true)); }

namespace pg8 {
constexpr int BM = 256, BK = 64, HALF = 128, HTB = HALF * BK * 2, STAGE_BYTES = 8 * HTB, NXCD = 8, WGM = 8;
__device__ __forceinline__ int lds_byte(int r, int c) { const int st = (r >> 4) * 2 + (c >> 5), rr = r & 15, cc = c & 31, ob = rr * 64 + cc * 2; return st * 1024 + (ob ^ (((ob >> 9) & 1) << 5)); }
__device__ __forceinline__ void stage_rc(int b, int& R, int& C) { const int st = b / 1024, sb = b % 1024, swz = sb ^ (((sb >> 9) & 1) << 5); R = (st >> 1) * 16 + swz / 64; C = (st & 1) * 32 + (swz % 64) / 2; }

struct Unit { int pm, pn, z, arow, sp; };
struct Gemm { const bf16_t* A; const bf16_t* Bt; int lda, ldb, K; long zA, zB; int krep; };

struct Sched {
    int nM, nN, nwg, G, c, nz, mode;
    __device__ void init(int nM_, int nN_, int G_, int c_, int nz_, int mode_) { nM = nM_; nN = nN_; nwg = nM * nN; G = G_; c = c_; nz = nz_; mode = mode_; }
    __device__ bool next(int i, Unit& u) const {
        const int iz = i % nz, it = i / nz;
        const long L = (long)it * G + c; if (L >= nwg) return false;
        int wgid = (int)L; { const int q = nwg / NXCD, r = nwg % NXCD, xcd = wgid % NXCD, off = wgid / NXCD; wgid = (xcd < r ? xcd * (q + 1) : r * (q + 1) + (xcd - r) * q) + off; }
        const int nig = WGM * nN, gid = wgid / nig, fm = gid * WGM, gsz = (nM - fm) < WGM ? (nM - fm) : WGM;
        u.pm = fm + ((wgid % nig) % gsz); u.pn = (wgid % nig) / gsz; u.z = iz;
        u.sp = 0;
        if (mode == 1) {
            if (u.pm < 128) { const int b = u.pm >> 3, ti = u.pm & 7; u.arow = b * SEQ + ti * 254 - 2; }
            else { u.sp = 1; u.arow = (u.pm - 128) * 8 * SEQ + (SEQ - 32); }
        } else u.arow = u.pm * BM;
        return true;
    }
};

template <class Epi>
__device__ __forceinline__ void gemm_phase(LAS unsigned char* lds, const Gemm g, const Sched& S, const Epi& E) {
    const int tid = tid_opaque(), wid = __builtin_amdgcn_readfirstlane(tid >> 6), lane = tid & 63, wr = wid >> 2, wc = wid & 3, fr = lane & 15, fq = lane >> 4;
    const int K = g.K, nt = (K / BK) * (g.krep > 1 ? 2 : 1), kmask = (g.krep > 1) ? (K / BK - 1) : 0x7fffffff;
    unsigned voffA[2], voffB[2];
#pragma unroll
    for (int i = 0; i < 2; ++i) { int R, C; stage_rc(tid * 16 + i * 8192, R, C); voffA[i] = (unsigned)(R * g.lda + C) * 2u; voffB[i] = (unsigned)(R * g.ldb + C) * 2u; }
    const size_t kstep = (size_t)(BK * 2);
    const size_t hstepA = (size_t)HALF * g.lda * 2, hstepB = (size_t)HALF * g.ldb * 2;
    unsigned voffS[2] = {0u, 0u}; const size_t hstepS = (size_t)4 * SEQ * g.lda * 2;
    if constexpr (Epi::SPECIAL_ROWS) {
#pragma unroll
        for (int i = 0; i < 2; ++i) { int R, C; stage_rc(tid * 16 + i * 8192, R, C); voffS[i] = (unsigned)(((R >> 5) * SEQ + (R & 31)) * g.lda + C) * 2u; }
    }
    const unsigned ldsw = (unsigned)wid * 1024u;
    const int aoff = lds_byte(wr * 64 + fr, fq * 8), boff = lds_byte(wc * 32 + fr, fq * 8);
#define PG8_SA(b, h) (((b) * 2 + (h)) * HTB)
#define PG8_SB(b, h) ((4 + (b) * 2 + (h)) * HTB)
#define PG8_STAGE(bufoff, gbase, voff) do { _Pragma("unroll") for (int _i = 0; _i < 2; ++_i) \
        __builtin_amdgcn_global_load_lds((const unsigned*)((const char*)(gbase) + (voff)[_i]), (LAS unsigned*)(lds + (bufoff) + ldsw + _i * 8192), 16, 0, 0); } while (0)
#define PG8_STAGE_A(bufoff, gbase, spf) do { _Pragma("unroll") for (int _i = 0; _i < 2; ++_i) \
        __builtin_amdgcn_global_load_lds((const unsigned*)((const char*)(gbase) + (Epi::SPECIAL_ROWS && (spf) ? voffS[_i] : voffA[_i])), (LAS unsigned*)(lds + (bufoff) + ldsw + _i * 8192), 16, 0, 0); } while (0)
#define PG8_LDA(dst, b, h) do { _Pragma("unroll") for (int m = 0; m < 4; ++m) _Pragma("unroll") for (int k = 0; k < 2; ++k) dst[m][k] = *(const LAS bf16x8*)(lds + PG8_SA(b, h) + aoff + m * 2048 + k * 1024); } while (0)
#define PG8_LDB(dst, b, h) do { _Pragma("unroll") for (int n = 0; n < 2; ++n) _Pragma("unroll") for (int k = 0; k < 2; ++k) dst[n][k] = *(const LAS bf16x8*)(lds + PG8_SB(b, h) + boff + n * 2048 + k * 1024); } while (0)
#define PG8_MMA(ai, bj, At, Bt) do { __builtin_amdgcn_s_setprio(1); _Pragma("unroll") for (int m = 0; m < 4; ++m) _Pragma("unroll") for (int n = 0; n < 2; ++n) _Pragma("unroll") for (int k = 0; k < 2; ++k) \
        acc[ai][bj][m][n] = __builtin_amdgcn_mfma_f32_16x16x32_bf16(Bt[n][k], At[m][k], acc[ai][bj][m][n], 0, 0, 0); __builtin_amdgcn_s_setprio(0); } while (0)
#define PG8_WAIT_V(n) asm volatile("s_waitcnt vmcnt(" #n ")" ::: "memory")
#define PG8_WAIT_L(n) asm volatile("s_waitcnt lgkmcnt(" #n ")" ::: "memory")
#define PG8_BAR __builtin_amdgcn_s_barrier()
#define PG8_SCHED __builtin_amdgcn_sched_barrier(0)
#define PG8_APTR(u) ((const char*)g.A + ((long)(u).z * g.zA + (long)(u).arow * g.lda) * 2)
#define PG8_BPTR(u) ((const char*)g.Bt + ((long)(u).z * g.zB + (long)(u).pn * BM * g.ldb) * 2)
    Unit cur, nxt; int ui = 0;
    if (!S.next(0, cur)) return;
    f32x4 acc[2][2][4][2];
#pragma unroll
    for (int a = 0; a < 2; ++a)
#pragma unroll
        for (int b = 0; b < 2; ++b)
#pragma unroll
            for (int m = 0; m < 4; ++m)
#pragma unroll
                for (int n = 0; n < 2; ++n) acc[a][b][m][n] = (f32x4){0.f, 0.f, 0.f, 0.f};
    bf16x8 At[4][2], B0[2][2], B1[2][2];
    const char* cA = PG8_APTR(cur); const char* cB = PG8_BPTR(cur);
    bool csp = false; size_t chA = hstepA;
    if constexpr (Epi::SPECIAL_ROWS) { if (cur.sp) { csp = true; chA = hstepS; } }
    PG8_STAGE(PG8_SB(0, 0), cB, voffB); PG8_STAGE(PG8_SB(0, 1), cB + hstepB, voffB); PG8_STAGE_A(PG8_SA(0, 0), cA, csp); PG8_STAGE_A(PG8_SA(0, 1), cA + chA, csp);
    if (wr == 1) PG8_BAR;
    PG8_WAIT_V(2); PG8_BAR;
    PG8_STAGE(PG8_SB(1, 0), cB + kstep, voffB); PG8_STAGE_A(PG8_SA(1, 0), cA + kstep, csp); PG8_STAGE(PG8_SB(1, 1), cB + hstepB + kstep, voffB);
    PG8_WAIT_V(6); PG8_BAR;
    for (;;) {
        const bool has_next = S.next(ui + 1, nxt);
        const char* nA = has_next ? PG8_APTR(nxt) : cA; const char* nB = has_next ? PG8_BPTR(nxt) : cB;
        bool nsp = csp; size_t nhA = chA;
        if constexpr (Epi::SPECIAL_ROWS) { if (has_next) { nsp = nxt.sp != 0; nhA = nsp ? hstepS : hstepA; } }
#pragma unroll 1
        for (int t = 0; t < nt; t += 2) {
            const bool last = (t == nt - 2);
            const char* a1 = cA + (size_t)((t + 1) & kmask) * kstep;
            const char* a2 = last ? nA : cA + (size_t)((t + 2) & kmask) * kstep; const char* b2 = last ? nB : cB + (size_t)((t + 2) & kmask) * kstep;
            const char* a3 = a2 + kstep; const char* b3 = b2 + kstep;
            const bool sp2 = last ? nsp : csp; const size_t hA2 = last ? nhA : chA;
            PG8_LDB(B0, 0, 0); PG8_LDB(B1, 0, 1); PG8_SCHED; PG8_LDA(At, 0, 0); PG8_STAGE_A(PG8_SA(1, 1), a1 + chA, csp);
            PG8_WAIT_V(8); PG8_WAIT_L(0); PG8_BAR; PG8_MMA(0, 0, At, B0); PG8_MMA(0, 1, At, B1); PG8_BAR; PG8_SCHED;
            PG8_LDA(At, 0, 1); PG8_STAGE(PG8_SB(0, 0), b2, voffB); PG8_STAGE(PG8_SB(0, 1), b2 + hstepB, voffB); PG8_STAGE_A(PG8_SA(0, 0), a2, sp2);
            PG8_WAIT_V(8); PG8_WAIT_L(0); PG8_BAR; PG8_MMA(1, 0, At, B0); PG8_MMA(1, 1, At, B1); PG8_BAR; PG8_SCHED;
            PG8_LDB(B0, 1, 0); PG8_LDB(B1, 1, 1); PG8_SCHED; PG8_LDA(At, 1, 0); PG8_STAGE_A(PG8_SA(0, 1), a2 + hA2, sp2);
            PG8_WAIT_V(8); PG8_WAIT_L(0); PG8_BAR; PG8_MMA(0, 0, At, B0); PG8_MMA(0, 1, At, B1); PG8_BAR; PG8_SCHED;
            PG8_LDA(At, 1, 1); PG8_STAGE(PG8_SB(1, 0), b3, voffB); PG8_STAGE(PG8_SB(1, 1), b3 + hstepB, voffB); PG8_STAGE_A(PG8_SA(1, 0), a3, sp2);
            PG8_WAIT_V(8); PG8_WAIT_L(0); PG8_BAR; PG8_MMA(1, 0, At, B0); PG8_MMA(1, 1, At, B1); PG8_BAR; PG8_SCHED;
        }
        if (wr == 0) PG8_BAR;
        E(acc, cur, wr, wc, fr, fq, lds + STAGE_BYTES);
        if (!has_next) break;
        if constexpr (!Epi::KEEP_ACC) {
#pragma unroll
        for (int a = 0; a < 2; ++a)
#pragma unroll
            for (int b = 0; b < 2; ++b)
#pragma unroll
                for (int m = 0; m < 4; ++m)
#pragma unroll
                    for (int n = 0; n < 2; ++n) acc[a][b][m][n] = (f32x4){0.f, 0.f, 0.f, 0.f};
        }
        cur = nxt; cA = nA; cB = nB; ++ui; csp = nsp; chA = nhA;
        if (wr == 1) PG8_BAR;
    }
    PG8_WAIT_V(0);
    PG8_BAR;
#undef PG8_SA
#undef PG8_SB
#undef PG8_STAGE
#undef PG8_STAGE_A
#undef PG8_LDA
#undef PG8_LDB
#undef PG8_MMA
#undef PG8_WAIT_V
#undef PG8_WAIT_L
#undef PG8_BAR
#undef PG8_SCHED
#undef PG8_APTR
#undef PG8_BPTR
}
}
using pg8::Unit;
typedef f32x4 AccT[2][2][4][2];

struct EpiIn1 {
    static constexpr bool KEEP_ACC = false, SPECIAL_ROWS = false;
    const float* ssqx; bf16_t *cq, *ckv, *qf, *kf, *vf, *ub; float *ssq_cq, *ssq_ckv, *ssq_kr, *kr_rot, *logf;
    const float *cosT, *sinT, *gk_mla, *gq_fox, *gk_fox, *fbias;
    __device__ __forceinline__ void operator()(AccT& acc, const Unit& u, int wr, int wc, int fr, int fq, LAS unsigned char*) const {
        const long row0 = (long)u.pm * 256 + wr * 64 + fr;
        float rsa[2][4]; row_scales<16>(rsa, ssqx, row0, fq, 1.f / 1024.f);
#pragma unroll
        for (int ai = 0; ai < 2; ++ai)
#pragma unroll
            for (int m = 0; m < 4; ++m) {
                const long row = row0 + ai * 128 + m * 16;
                const float rs = rsa[ai][m];
                f32x4 v[2][2];
#pragma unroll
                for (int bj = 0; bj < 2; ++bj)
#pragma unroll
                    for (int n = 0; n < 2; ++n) v[bj][n] = acc[ai][bj][m][n] * rs;
                const int cl = wc * 32 + 8 * fq;
                if (u.pn == 0 || u.pn == 2 || u.pn == 5 || u.pn == 6) {
                    bf16_t* dst = (u.pn == 0) ? cq + row * 384 : (u.pn == 2) ? ckv + row * 256 : (u.pn == 5) ? vf + row * 256 : ub + row * 256;
                    float ss = 0.f;
#pragma unroll
                    for (int bj = 0; bj < 2; ++bj) { store8(dst + bj * 128 + cl, v[bj][0], v[bj][1]); ss += dot4(v[bj][0]) + dot4(v[bj][1]); }
                    if (u.pn == 0 || u.pn == 2) { ss = red_fq(ss); if (fq == 0) { if (u.pn == 0) ssq_cq[row * 8 + wc] = ss; else ssq_ckv[row * 4 + wc] = ss; } }
                } else if (u.pn == 1) {
                    float ss = 0.f;
                    store8(cq + row * 384 + 256 + cl, v[0][0], v[0][1]); ss += dot4(v[0][0]) + dot4(v[0][1]);
                    ss = red_fq(ss); if (fq == 0) ssq_cq[row * 8 + 4 + wc] = ss;
                    if (wc == 0) {
                        float sk = red_fq(dot4(v[1][0]) + dot4(v[1][1])); if (fq == 0) ssq_kr[row] = sk;
                        const f32x4 g1 = *(const f32x4*)(gk_mla + 64 + 4 * fq), g2 = *(const f32x4*)(gk_mla + 80 + 4 * fq);
                        const f32x4 cs = *(const f32x4*)(cosT + row * 16 + 4 * fq), sn = *(const f32x4*)(sinT + row * 16 + 4 * fq);
                        const f32x4 a1 = v[1][0] * g1, a2 = v[1][1] * g2;
                        *(f32x4*)(kr_rot + row * 32 + 4 * fq) = a1 * cs - a2 * sn;
                        *(f32x4*)(kr_rot + row * 32 + 16 + 4 * fq) = a2 * cs + a1 * sn;
                    } else if (wc == 1 && fq == 0) {
                        const f32x4 fb = *(const f32x4*)fbias; f32x4 z = v[1][0] + fb, o;
#pragma unroll
                        for (int i = 0; i < 4; ++i) o[i] = fminf(z[i], 0.f) - 0.6931471805599453f * __builtin_amdgcn_logf(1.f + __builtin_amdgcn_exp2f(-fabsf(z[i]) * LOG2E));
                        *(f32x4*)(logf + row * 4) = o;
                    }
                } else {
                    float ss = 0.f;
#pragma unroll
                    for (int bj = 0; bj < 2; ++bj)
#pragma unroll
                        for (int n = 0; n < 2; ++n) ss += dot4(v[bj][n]);
                    ss = red_fq(ss);
                    const float rh = rsqrtf(ss * (1.f / 64.f) + EPS) * (u.pn == 3 ? 0.125f * LOG2E : 1.f);
                    const float* gg = (u.pn == 3) ? gq_fox : gk_fox; bf16_t* dst = ((u.pn == 3) ? qf : kf) + row * 256 + wc * 64 + 8 * fq;
#pragma unroll
                    for (int bj = 0; bj < 2; ++bj) { const f32x4 g0 = *(const f32x4*)(gg + 32 * bj + 8 * fq), g1 = *(const f32x4*)(gg + 32 * bj + 8 * fq + 4); store8(dst + 32 * bj, v[bj][0] * g0 * rh, v[bj][1] * g1 * rh); }
                }
            }
    }
};
struct EpiGates {
    static constexpr bool KEEP_ACC = false, SPECIAL_ROWS = false;
    const float* ssqx; bf16_t* gates;
    __device__ __forceinline__ void operator()(AccT& acc, const Unit& u, int wr, int wc, int fr, int fq, LAS unsigned char*) const {
        const long row0 = (long)u.pm * 256 + wr * 64 + fr;
        const size_t tb = ((size_t)(u.pm * 12 + u.pn) * 8 + (wr * 4 + wc)) * 16; const int lane = fq * 16 + fr;
        float rsa[2][4]; row_scales<16>(rsa, ssqx, row0, fq, 1.f / 1024.f);
#pragma unroll
        for (int ai = 0; ai < 2; ++ai)
#pragma unroll
            for (int m = 0; m < 4; ++m) {
                const float rs = rsa[ai][m] * -LOG2E;
#define SG_(t) __builtin_amdgcn_rcpf(1.f + __builtin_amdgcn_exp2f(min2f(t, 19.931568f)))
#pragma unroll
                for (int bj = 0; bj < 2; ++bj) { const f32x4 v0 = acc[ai][bj][m][0] * rs, v1 = acc[ai][bj][m][1] * rs; u32x4 w;
                    w.x = pk2(SG_(v0.x), SG_(v0.y)); w.y = pk2(SG_(v0.z), SG_(v0.w)); w.z = pk2(SG_(v1.x), SG_(v1.y)); w.w = pk2(SG_(v1.z), SG_(v1.w));
#undef SG_
                    *(u32x4*)(gates + ((tb + (ai * 4 + m) * 2 + bj) * 64 + lane) * 8) = w; }
            }
    }
};
struct EpiUq {
    static constexpr bool KEEP_ACC = false, SPECIAL_ROWS = false;
    const float* ssq_cq; bf16_t* qm; float *ssq_qn, *ssq_qr; const float *cosT, *sinT, *gq;
    __device__ __forceinline__ void operator()(AccT& acc, const Unit& u, int wr, int wc, int fr, int fq, LAS unsigned char*) const {
        const long row0 = (long)u.pm * 256 + wr * 64 + fr;
        float rsa[2][4]; row_scales<8>(rsa, ssq_cq, row0, fq, 1.f / 384.f);
        if (u.pn == 0) {
            f32x4 gv[2][2];
#pragma unroll
            for (int bj = 0; bj < 2; ++bj)
#pragma unroll
                for (int n = 0; n < 2; ++n) gv[bj][n] = *(const f32x4*)(gq + 32 * bj + 8 * fq + 4 * n);
#pragma unroll
            for (int ai = 0; ai < 2; ++ai)
#pragma unroll
                for (int m = 0; m < 4; ++m) { const long row = row0 + ai * 128 + m * 16; const float rs = rsa[ai][m]; float ss = 0.f;
#pragma unroll
                    for (int bj = 0; bj < 2; ++bj) { const f32x4 v0 = acc[ai][bj][m][0] * rs, v1 = acc[ai][bj][m][1] * rs; ss += dot4(v0) + dot4(v1); store8(qm + row * 384 + wc * 96 + 32 * bj + 8 * fq, v0 * gv[bj][0], v1 * gv[bj][1]); }
                    ss = red_fq(ss); if (fq == 0) ssq_qn[row * 4 + wc] = ss; }
        } else {
            const f32x4 g1 = *(const f32x4*)(gq + 64 + 4 * fq), g2 = *(const f32x4*)(gq + 80 + 4 * fq);
#pragma unroll
            for (int ai = 0; ai < 2; ++ai) {
                f32x4 cs[4], sn[4];
#pragma unroll
                for (int m = 0; m < 4; ++m) { const long row = row0 + ai * 128 + m * 16; cs[m] = *(const f32x4*)(cosT + row * 16 + 4 * fq); sn[m] = *(const f32x4*)(sinT + row * 16 + 4 * fq); }
#pragma unroll
                for (int m = 0; m < 4; ++m) { const long row = row0 + ai * 128 + m * 16; const float rs = rsa[ai][m];
                    const f32x4 x1 = acc[ai][0][m][0] * rs, x2 = acc[ai][0][m][1] * rs;
                    float ss = red_fq(dot4(x1) + dot4(x2)); if (fq == 0) ssq_qr[row * 4 + wc] = ss;
                    const f32x4 a1 = x1 * g1, a2 = x2 * g2;
                    store4(qm + row * 384 + wc * 96 + 64 + 4 * fq, a1 * cs[m] - a2 * sn[m]);
                    store4(qm + row * 384 + wc * 96 + 80 + 4 * fq, a2 * cs[m] + a1 * sn[m]); }
                asm volatile("" ::: "memory");
            }
        }
    }
};
struct EpiUkv {
    static constexpr bool KEEP_ACC = false, SPECIAL_ROWS = false;
    const float *ssq_ckv, *ssq_kr, *kr_rot, *gk; bf16_t *km, *vm;
    __device__ __forceinline__ void operator()(AccT& acc, const Unit& u, int wr, int wc, int fr, int fq, LAS unsigned char*) const {
        const long row0 = (long)u.pm * 256 + wr * 64 + fr;
        float rsa[2][4]; row_scales<4>(rsa, ssq_ckv, row0, fq, 1.f / 256.f);
        if (u.pn == 0) {
            f32x4 gv[2][2];
#pragma unroll
            for (int bj = 0; bj < 2; ++bj)
#pragma unroll
                for (int n = 0; n < 2; ++n) gv[bj][n] = *(const f32x4*)(gk + 32 * bj + 8 * fq + 4 * n);
#pragma unroll
            for (int ai = 0; ai < 2; ++ai) {
                float skr[4]; f32x4 kr0[4], kr1[4];
#pragma unroll
                for (int m = 0; m < 4; ++m) { const long row = row0 + ai * 128 + m * 16; skr[m] = ssq_kr[row]; kr0[m] = *(const f32x4*)(kr_rot + row * 32 + 8 * fq); kr1[m] = *(const f32x4*)(kr_rot + row * 32 + 8 * fq + 4); }
#pragma unroll
                for (int m = 0; m < 4; ++m) {
                    const long row = row0 + ai * 128 + m * 16; const float rs = rsa[ai][m];
                    f32x4 v[2][2]; float ss = 0.f;
#pragma unroll
                    for (int bj = 0; bj < 2; ++bj)
#pragma unroll
                        for (int n = 0; n < 2; ++n) { v[bj][n] = acc[ai][bj][m][n] * rs; ss += dot4(v[bj][n]); }
                    ss = red_fq(ss) + skr[m];
                    const float rk = rsqrtf(ss * (1.f / 96.f) + EPS);
#pragma unroll
                    for (int bj = 0; bj < 2; ++bj) store8(km + row * 384 + wc * 96 + 32 * bj + 8 * fq, v[bj][0] * gv[bj][0] * rk, v[bj][1] * gv[bj][1] * rk);
                    const f32x4 r0 = kr0[m] * rk, r1 = kr1[m] * rk;
                    u32x4 w; w.x = pk2(r0.x, r0.y); w.y = pk2(r0.z, r0.w); w.z = pk2(r1.x, r1.y); w.w = pk2(r1.z, r1.w);
                    *(u32x4*)(km + row * 384 + wc * 96 + 64 + 8 * fq) = w;
                }
                asm volatile("" ::: "memory");
            }
        } else {
#pragma unroll
            for (int ai = 0; ai < 2; ++ai)
#pragma unroll
                for (int m = 0; m < 4; ++m) { const long row = row0 + ai * 128 + m * 16; const float rs = rsa[ai][m];
#pragma unroll
                    for (int bj = 0; bj < 2; ++bj) { const f32x4 y0 = acc[ai][bj][m][0] * rs, y1 = acc[ai][bj][m][1] * rs; u32x4 w; w.x = pk2(y0.x, y0.y); w.y = pk2(y0.z, y0.w); w.z = pk2(y1.x, y1.y); w.w = pk2(y1.z, y1.w);
                        *(u32x4*)(vm + row * 256 + bj * 128 + wc * 32 + 8 * fq) = w; } }
        }
    }
};
struct EpiGlu {
    static constexpr bool KEEP_ACC = false, SPECIAL_ROWS = false;
    const bf16_t* y2; const float* bglu; bf16_t* os5;
    __device__ __forceinline__ void operator()(AccT& acc, const Unit& u, int wr, int wc, int fr, int fq, LAS unsigned char*) const {
        const long row0 = (long)u.pm * 256 + wr * 64 + fr; const int colb = wc * 32 + 8 * fq;
        f32x4 bv[2][2];
#pragma unroll
        for (int bj = 0; bj < 2; ++bj)
#pragma unroll
            for (int n = 0; n < 2; ++n) bv[bj][n] = *(const f32x4*)(bglu + bj * 128 + 4 * n + colb);
#pragma unroll
        for (int ai = 0; ai < 2; ++ai) {
            u32x4 yw[4][2];
#pragma unroll
            for (int m = 0; m < 4; ++m)
#pragma unroll
                for (int bj = 0; bj < 2; ++bj) yw[m][bj] = *(const u32x4*)(y2 + (row0 + ai * 128 + m * 16) * 256 + bj * 128 + colb);
#pragma unroll
            for (int m = 0; m < 4; ++m)
#pragma unroll
                for (int bj = 0; bj < 2; ++bj) { const u32x4 w = yw[m][bj];
                    const f32x4 y0 = (f32x4){__uint_as_float(w.x << 16), __uint_as_float(w.x & 0xffff0000u), __uint_as_float(w.y << 16), __uint_as_float(w.y & 0xffff0000u)};
                    const f32x4 y1 = (f32x4){__uint_as_float(w.z << 16), __uint_as_float(w.z & 0xffff0000u), __uint_as_float(w.w << 16), __uint_as_float(w.w & 0xffff0000u)};
                    const f32x4 z0 = acc[ai][bj][m][0] + bv[bj][0], z1 = acc[ai][bj][m][1] + bv[bj][1]; f32x4 o0, o1;
#pragma unroll
                    for (int i = 0; i < 4; ++i) { o0[i] = y0[i] * sigmoidf_(z0[i]); o1[i] = y1[i] * sigmoidf_(z1[i]); }
                    u32x4 o; o.x = pk2(o0.x, o0.y); o.y = pk2(o0.z, o0.w); o.z = pk2(o1.x, o1.y); o.w = pk2(o1.z, o1.w);
                    *(u32x4*)(os5 + (row0 + ai * 128 + m * 16) * 256 + bj * 128 + colb) = o; }
            asm volatile("" ::: "memory");
        }
    }
};
struct EpiWb {
    static constexpr bool KEEP_ACC = true, SPECIAL_ROWS = false;
    const bf16_t* gates; bf16_t* merged;
    static __device__ __forceinline__ void unpack8(const u32x4 w, f32x4& a, f32x4& b) {
        a.x = __uint_as_float(w.x << 16); a.y = __uint_as_float(w.x & 0xffff0000u); a.z = __uint_as_float(w.y << 16); a.w = __uint_as_float(w.y & 0xffff0000u);
        b.x = __uint_as_float(w.z << 16); b.y = __uint_as_float(w.z & 0xffff0000u); b.z = __uint_as_float(w.w << 16); b.w = __uint_as_float(w.w & 0xffff0000u);
    }
    __device__ __forceinline__ void operator()(AccT& acc, const Unit& u, int wr, int wc, int fr, int fq, LAS unsigned char*) const {
        const long row0 = (long)u.pm * 256 + wr * 64 + fr;
        const size_t tb = ((size_t)(u.pm * 12 + u.z * 4 + u.pn) * 8 + (wr * 4 + wc)) * 16; const int lane = fq * 16 + fr;
        constexpr size_t ZSTEP = (size_t)4 * 8 * 16 * 64 * 8;
        const bool more = (u.z < 2);
#pragma unroll
        for (int ai = 0; ai < 2; ++ai) {
            u32x4 gw[8], nw[8];
#pragma unroll
            for (int j = 0; j < 8; ++j) { const bf16_t* gp = gates + ((tb + ai * 8 + j) * 64 + lane) * 8; gw[j] = *(const u32x4*)gp; nw[j] = *(const u32x4*)(gp + (more ? ZSTEP : 0)); }
#pragma unroll
            for (int m = 0; m < 4; ++m)
#pragma unroll
                for (int bj = 0; bj < 2; ++bj) {
                    f32x4 g0, g1; unpack8(gw[m * 2 + bj], g0, g1);
                    if (more) {
                        f32x4 h0, h1; unpack8(nw[m * 2 + bj], h0, h1);
#pragma unroll
                        for (int i = 0; i < 4; ++i) { acc[ai][bj][m][0][i] *= g0[i] * __builtin_amdgcn_rcpf(h0[i]); acc[ai][bj][m][1][i] *= g1[i] * __builtin_amdgcn_rcpf(h1[i]); }
                    } else {
                        const long off = (row0 + ai * 128 + m * 16) * 1024 + u.pn * 256 + bj * 128 + wc * 32 + 8 * fq;
                        const f32x4 y0 = acc[ai][bj][m][0] * g0, y1 = acc[ai][bj][m][1] * g1; u32x4 w; w.x = pk2(y0.x, y0.y); w.y = pk2(y0.z, y0.w); w.z = pk2(y1.x, y1.y); w.w = pk2(y1.z, y1.w);
                        *(u32x4*)(merged + off) = w;
                        acc[ai][bj][m][0] = (f32x4){0.f, 0.f, 0.f, 0.f}; acc[ai][bj][m][1] = (f32x4){0.f, 0.f, 0.f, 0.f};
                    }
                }
            asm volatile("" ::: "memory");
        }
    }
};
struct EpiRes {
    static constexpr bool KEEP_ACC = false, SPECIAL_ROWS = false;
    const float* xin; float* xout; bf16_t* xb; float* ssqx;
    __device__ __forceinline__ void operator()(AccT& acc, const Unit& u, int wr, int wc, int fr, int fq, LAS unsigned char*) const {
        const long row0 = (long)u.pm * 256 + wr * 64 + fr; const int colb = u.pn * 256 + wc * 32 + 8 * fq;
#pragma unroll
        for (int ai = 0; ai < 2; ++ai) {
            f32x4 xo[4][2][2];
            if (xin) {
#pragma unroll
                for (int m = 0; m < 4; ++m)
#pragma unroll
                    for (int bj = 0; bj < 2; ++bj)
#pragma unroll
                        for (int n = 0; n < 2; ++n) xo[m][bj][n] = *(const f32x4*)(xin + (row0 + ai * 128 + m * 16) * 1024 + colb + bj * 128 + 4 * n);
            } else {
                u32x4 xw[4][2];
#pragma unroll
                for (int m = 0; m < 4; ++m)
#pragma unroll
                    for (int bj = 0; bj < 2; ++bj) xw[m][bj] = *(const u32x4*)(xb + (row0 + ai * 128 + m * 16) * 1024 + colb + bj * 128);
#pragma unroll
                for (int m = 0; m < 4; ++m)
#pragma unroll
                    for (int bj = 0; bj < 2; ++bj) { const u32x4 w = xw[m][bj];
                        xo[m][bj][0] = (f32x4){__uint_as_float(w.x << 16), __uint_as_float(w.x & 0xffff0000u), __uint_as_float(w.y << 16), __uint_as_float(w.y & 0xffff0000u)};
                        xo[m][bj][1] = (f32x4){__uint_as_float(w.z << 16), __uint_as_float(w.z & 0xffff0000u), __uint_as_float(w.w << 16), __uint_as_float(w.w & 0xffff0000u)}; }
            }
#pragma unroll
            for (int m = 0; m < 4; ++m) {
                const long row = row0 + ai * 128 + m * 16; float ss = 0.f;
#pragma unroll
                for (int bj = 0; bj < 2; ++bj) { const long off = row * 1024 + colb + bj * 128;
                    const f32x4 x0 = xo[m][bj][0] + acc[ai][bj][m][0], x1 = xo[m][bj][1] + acc[ai][bj][m][1];
                    u32x4 w; w.x = pk2(x0.x, x0.y); w.y = pk2(x0.z, x0.w); w.z = pk2(x1.x, x1.y); w.w = pk2(x1.z, x1.w);
                    if (xout) { *(f32x4*)(xout + off) = x0; *(f32x4*)(xout + off + 4) = x1; }
                    else { *(u32x4*)(xb + off) = w; ss += dot4(x0) + dot4(x1); } }
                if (!xout) { ss = red_fq(ss); if (fq == 0) ssqx[row * 16 + u.pn * 4 + wc] = ss; }
            }
            asm volatile("" ::: "memory");
        }
    }
};
struct EpiUp {
    static constexpr bool KEEP_ACC = false, SPECIAL_ROWS = true;
    const float* ssqx; const float* cw; bf16_t* act;
    __device__ __forceinline__ long tok_row(const Unit& u, int ai, int wr, int m, int fr) const {
        if (u.sp) return (long)((u.pm - 128) * 8 + 4 * ai + 2 * wr + (m >> 1)) * SEQ + (SEQ - 32) + 16 * (m & 1) + fr;
        const int t = (u.pm & 7) * 254 - 2 + ai * 128 + wr * 64 + m * 16 + fr;
        return t < 0 ? -1 : (long)(u.pm >> 3) * SEQ + t;
    }
    __device__ __forceinline__ void operator()(AccT& acc, const Unit& u, int wr, int wc, int fr, int fq, LAS unsigned char* ldsx) const {
        asm volatile("" : "+v"(fr), "+v"(fq));
        { float tt[2][4];
#pragma unroll
        for (int ai = 0; ai < 2; ++ai)
#pragma unroll
            for (int m = 0; m < 4; ++m) { const long tr = tok_row(u, ai, wr, m, fr);
                const f32x4 v = *(const f32x4*)(ssqx + (tr < 0 ? 0 : tr) * 16 + 4 * fq); tt[ai][m] = (v.x + v.y) + (v.z + v.w); }
#pragma unroll
        for (int ai = 0; ai < 2; ++ai)
#pragma unroll
            for (int m = 0; m < 4; ++m) {
                const bool ok = tok_row(u, ai, wr, m, fr) >= 0;
                const float rs = ok ? rsqrtf(red_fq(tt[ai][m]) * (1.f / 1024.f) + EPS) * (PROBE_KREP == 8 ? 0.5f : 1.f) : 0.f;
#pragma unroll
                for (int bj = 0; bj < 2; ++bj)
#pragma unroll
                    for (int n = 0; n < 2; ++n) acc[ai][bj][m][n] *= rs;
            } }
        LAS float* xch = (LAS float*)ldsx;
        if (fr >= 14) {
#pragma unroll
            for (int ai = 0; ai < 2; ++ai) { const int s = ai * 2 + wr;
#pragma unroll
                for (int bj = 0; bj < 2; ++bj)
#pragma unroll
                    for (int n = 0; n < 2; ++n) *(LAS f32x4*)(xch + ((s * 2 + (fr - 14)) * 256 + bj * 128 + wc * 32 + n * 16 + 4 * fq)) = acc[ai][bj][3][n]; }
        }
        asm volatile("s_waitcnt lgkmcnt(0)" ::: "memory"); __builtin_amdgcn_s_barrier(); asm volatile("" ::: "memory");
        const bool hi1 = (fr == 15), hi2 = (fr >= 14);
        const int ch = u.pn * 128 + wc * 32 + 8 * fq;
        f32x4 wg[2][3], wv[2][3];
#pragma unroll
        for (int n = 0; n < 2; ++n)
#pragma unroll
            for (int j = 0; j < 3; ++j) { wg[n][j] = *(const f32x4*)(cw + j * 5632 + ch + 4 * n); wv[n][j] = *(const f32x4*)(cw + j * 5632 + DFF + ch + 4 * n); }
#pragma unroll
        for (int ai = 0; ai < 2; ++ai) {
            const int s = ai * 2 + wr;
            f32x4 pg[2], pv[2];
#pragma unroll
            for (int n = 0; n < 2; ++n) { pg[n] = (f32x4){0.f, 0.f, 0.f, 0.f}; pv[n] = pg[n]; }
            if (s > 0 && fr >= 14) {
#pragma unroll
                for (int n = 0; n < 2; ++n) { const LAS float* q = xch + (((s - 1) * 2 + (fr - 14)) * 256 + wc * 32 + n * 16 + 4 * fq); pg[n] = *(const LAS f32x4*)q; pv[n] = *(const LAS f32x4*)(q + 128); }
            }
#pragma unroll
            for (int m = 0; m < 4; ++m) {
                u32x4 w;
#pragma unroll
                for (int n = 0; n < 2; ++n) {
                    const f32x4 cg = acc[ai][0][m][n], cv = acc[ai][1][m][n]; f32x4 o;
                    float og[4];
                    { float s1[4], s2[4];
#pragma unroll
                      for (int i = 0; i < 4; ++i) { s1[i] = hi1 ? pg[n][i] : cg[i]; s2[i] = hi2 ? pg[n][i] : cg[i]; }
#pragma unroll
                      for (int i = 0; i < 4; ++i) { s1[i] = dpp_ror1(s1[i]); s2[i] = dpp_ror2(s2[i]); }
#pragma unroll
                      for (int i = 0; i < 4; ++i) og[i] = wg[n][2][i] * cg[i] + wg[n][1][i] * s1[i] + wg[n][0][i] * s2[i]; }
                    { float s1[4], s2[4];
#pragma unroll
                      for (int i = 0; i < 4; ++i) { s1[i] = hi1 ? pv[n][i] : cv[i]; s2[i] = hi2 ? pv[n][i] : cv[i]; }
#pragma unroll
                      for (int i = 0; i < 4; ++i) { s1[i] = dpp_ror1(s1[i]); s2[i] = dpp_ror2(s2[i]); }
#pragma unroll
                      for (int i = 0; i < 4; ++i) { const float ov = wv[n][2][i] * cv[i] + wv[n][1][i] * s1[i] + wv[n][0][i] * s2[i]; o[i] = og[i] * sigmoidf_(og[i]) * ov; } }
                    w[2 * n] = pk2(o[0], o[1]); w[2 * n + 1] = pk2(o[2], o[3]);
                    pg[n] = cg; pv[n] = cv;
                }
                const bool st = u.sp ? ((m & 1) != 0) : (ai * 128 + wr * 64 + m * 16 + fr >= 2);
                if (st) *(u32x4*)(act + tok_row(u, ai, wr, m, fr) * DFF + ch) = w;
            }
        }
    }
};

template <bool MLA>
__device__ __forceinline__ void attn_unit(LAS unsigned char* lds, const bf16_t* Q, const bf16_t* Kp, const bf16_t* V, bf16_t* O, const float* ssq_qn, const float* ssq_qr, const float* cl, int b, int h, int qb) {
    constexpr int DK = MLA ? 96 : 64, NC = DK / 16, KP = MLA ? DK * 2 + 16 : DK * 2 + 32 + 16, KSEG = DK / 8, LDQ = MLA ? 384 : 256;
    constexpr int KBUF = 64 * 208, VP = 192, VBUF = 64 * VP, VOFF = 2 * KBUF, CKOFF = VOFF + 2 * VBUF;
    const int tid = tid_opaque(), w = tid >> 6, lane = tid & 63, r = lane & 31, hh = lane >> 5;
    const long rowb = (long)b * SEQ;
    const long qrow = rowb + qb * 256 + w * 32 + r;
    bf16x8 qfr[NC];
#pragma unroll
    for (int c = 0; c < NC; ++c) qfr[c] = *(const bf16x8*)(Q + qrow * LDQ + h * DK + 16 * c + 8 * hh);
    if (MLA) {
        const float s = rsqrtf((ssq_qn[qrow * 4 + h] + ssq_qr[qrow * 4 + h]) * (1.f / 96.f) + EPS) * (0.10206207261596574f * LOG2E);
#pragma unroll
        for (int c = 0; c < NC; ++c) { u32x4 wv = __builtin_bit_cast(u32x4, qfr[c]);
#pragma unroll
            for (int j = 0; j < 4; ++j) wv[j] = pk2(__uint_as_float(wv[j] << 16) * s, __uint_as_float(wv[j] & 0xffff0000u) * s);
            qfr[c] = __builtin_bit_cast(bf16x8, wv); }
    }
    const int ntile = 4 * (qb + 1);
    const int tq_lo = qb * 256 + w * 32, tq = tq_lo + r, tq_hi = tq_lo + 31;
    float m_run = -1e30f, l_run = 0.f;
    f32x16 o0, o1;
#pragma unroll
    for (int i = 0; i < 16; ++i) { o0[i] = 0.f; o1[i] = 0.f; }
    u32x4 kst0, kst1 = (u32x4){0, 0, 0, 0}, vst; float cst = 0.f;
    const int kr0 = tid / KSEG, ksg0 = tid % KSEG, kr1 = (tid + 512) / KSEG, ksg1 = (tid + 512) % KSEG;
    const int vkv = tid >> 3, vds = tid & 7;
    const bf16_t* kq0 = Kp + (rowb + kr0) * LDQ + h * DK + 8 * ksg0; const bf16_t* kq1 = Kp + (rowb + kr1) * LDQ + h * DK + 8 * ksg1;
    const bf16_t* vq = V + (rowb + vkv) * 256 + h * 64 + 8 * vds; const float* cq_ = cl + (rowb + (tid & 63)) * 4 + h;
#define AT_LOAD(j) do { \
        kst0 = *(const u32x4*)kq0; kq0 += 64 * LDQ; \
        if (MLA && tid < 256) { kst1 = *(const u32x4*)kq1; kq1 += 64 * LDQ; } \
        vst = *(const u32x4*)vq; vq += 64 * 256; \
        if (!MLA && tid < 64) { cst = -*cq_; cq_ += 64 * 4; } } while (0)
#define AT_WRITE(buf) do { \
        *(LAS u32x4*)(lds + (buf) * KBUF + kr0 * KP + ksg0 * 16) = kst0; \
        if (MLA && tid < 256) *(LAS u32x4*)(lds + (buf) * KBUF + kr1 * KP + ksg1 * 16) = kst1; \
        *(LAS u32x4*)(lds + VOFF + (buf) * VBUF + vkv * VP + vds * 16) = vst; \
        if (!MLA && tid < 64) { const unsigned hi_ = pk2(cst, 0.f) & 0xffffu; const unsigned lo_ = pk2(cst - __uint_as_float(hi_ << 16), 0.f) & 0xffffu; \
            LAS u32x4* ap_ = (LAS u32x4*)(lds + (buf) * KBUF + tid * KP + 128); unsigned z_ = 0u; asm volatile("" : "+v"(z_)); ap_[0] = (u32x4){hi_ | (lo_ << 16), z_, z_, z_}; ap_[1] = (u32x4){z_, z_, z_, z_}; } } while (0)
    AT_LOAD(0); AT_WRITE(0); __syncthreads();
    for (int j = 0; j < ntile; ++j) {
        const int buf = j & 1;
        if (j + 1 < ntile) AT_LOAD(j + 1);
        if (64 * j <= tq_hi) {
            const LAS unsigned char* kb = lds + buf * KBUF + r * KP + hh * 16;
            f32x16 p0, p1;
#pragma unroll
            for (int i = 0; i < 16; ++i) { p0[i] = 0.f; p1[i] = 0.f; }
            if (!MLA) {
                unsigned zq = 0u; asm volatile("" : "+v"(zq)); const u32x4 qaw = (u32x4){hh == 0 ? 0x3f803f80u : zq, zq, zq, zq}; const bf16x8 qaug = __builtin_bit_cast(bf16x8, qaw);
                const bf16x8 a0 = *(const LAS bf16x8*)(kb + 128), a1 = *(const LAS bf16x8*)(kb + 32 * KP + 128);
                p0 = __builtin_amdgcn_mfma_f32_32x32x16_bf16(a0, qaug, p0, 0, 0, 0);
                p1 = __builtin_amdgcn_mfma_f32_32x32x16_bf16(a1, qaug, p1, 0, 0, 0);
            }
#pragma unroll
            for (int c = 0; c < NC; ++c) {
                const bf16x8 a0 = *(const LAS bf16x8*)(kb + c * 32), a1 = *(const LAS bf16x8*)(kb + 32 * KP + c * 32);
                p0 = __builtin_amdgcn_mfma_f32_32x32x16_bf16(a0, qfr[c], p0, 0, 0, 0);
                p1 = __builtin_amdgcn_mfma_f32_32x32x16_bf16(a1, qfr[c], p1, 0, 0, 0);
            }
            if (64 * j + 63 > tq_lo) {
#pragma unroll
                for (int rg = 0; rg < 16; ++rg) { const int kv = 64 * j + (rg & 3) + 8 * (rg >> 2) + 4 * hh;
                    if (kv > tq) p0[rg] = -1e30f; if (kv + 32 > tq) p1[rg] = -1e30f; }
            }
            float mxa = max3f(p0[0], p0[1], p1[0]), mxb = max3f(p0[2], p0[3], p1[1]); mxa = max3f(mxa, p1[2], p1[3]);
#pragma unroll
            for (int i = 4; i < 16; i += 4) { mxa = max3f(mxa, p0[i], p0[i + 1]); mxb = max3f(mxb, p0[i + 2], p0[i + 3]); mxa = max3f(mxa, p1[i], p1[i + 1]); mxb = max3f(mxb, p1[i + 2], p1[i + 3]); }
            float mx = max2f(mxa, mxb);
            mx = max2f(mx, __shfl_xor(mx, 32));
            const float m_new = max2f(m_run, mx);
            float ls = 0.f;
#pragma unroll
            for (int i = 0; i < 16; ++i) { p0[i] = __builtin_amdgcn_exp2f(p0[i] - m_new); p1[i] = __builtin_amdgcn_exp2f(p1[i] - m_new); ls += p0[i] + p1[i]; }
            if (__any(m_new > m_run)) {
                const float alpha = __builtin_amdgcn_exp2f(m_run - m_new);
                l_run *= alpha;
#pragma unroll
                for (int i = 0; i < 16; ++i) { o0[i] *= alpha; o1[i] *= alpha; }
            }
            l_run += ls; m_run = m_new;
            bf16x8 pb[4];
#pragma unroll
            for (int s = 0; s < 4; ++s) { u32x4 wv;
#pragma unroll
                for (int jj = 0; jj < 4; ++jj) wv[jj] = (s < 2) ? pk2(p0[8 * (s & 1) + 2 * jj], p0[8 * (s & 1) + 2 * jj + 1]) : pk2(p1[8 * (s & 1) + 2 * jj], p1[8 * (s & 1) + 2 * jj + 1]);
                pb[s] = __builtin_bit_cast(bf16x8, wv); }
            const LAS unsigned char* vb = lds + VOFF + buf * VBUF + (4 * hh + ((r & 15) >> 2)) * VP + (16 * (r >> 4) + 4 * (r & 3)) * 2;
#pragma unroll
            for (int s = 0; s < 4; ++s) {
                const v4i16_t lo0 = __builtin_amdgcn_ds_read_tr16_b64_v4i16((LAS v4i16_t*)(vb + s * 16 * VP)), hi0 = __builtin_amdgcn_ds_read_tr16_b64_v4i16((LAS v4i16_t*)(vb + s * 16 * VP + 8 * VP));
                const v4i16_t lo1 = __builtin_amdgcn_ds_read_tr16_b64_v4i16((LAS v4i16_t*)(vb + s * 16 * VP + 64)), hi1 = __builtin_amdgcn_ds_read_tr16_b64_v4i16((LAS v4i16_t*)(vb + s * 16 * VP + 8 * VP + 64));
                const bf16x8 a0 = (bf16x8){lo0[0], lo0[1], lo0[2], lo0[3], hi0[0], hi0[1], hi0[2], hi0[3]}, a1 = (bf16x8){lo1[0], lo1[1], lo1[2], lo1[3], hi1[0], hi1[1], hi1[2], hi1[3]};
                o0 = __builtin_amdgcn_mfma_f32_32x32x16_bf16(a0, pb[s], o0, 0, 0, 0);
                o1 = __builtin_amdgcn_mfma_f32_32x32x16_bf16(a1, pb[s], o1, 0, 0, 0);
            }
        }
        if (j + 1 < ntile) AT_WRITE(buf ^ 1);
        __syncthreads();
    }
#undef AT_LOAD
#undef AT_WRITE
    const float lt = l_run + __shfl_xor(l_run, 32), inv = 1.f / lt;
    bf16_t* op = O + qrow * 256 + h * 64 + 4 * hh;
#pragma unroll
    for (int g = 0; g < 4; ++g) {
        store4(op + 8 * g, (f32x4){o0[4 * g] * inv, o0[4 * g + 1] * inv, o0[4 * g + 2] * inv, o0[4 * g + 3] * inv});
        store4(op + 32 + 8 * g, (f32x4){o1[4 * g] * inv, o1[4 * g + 1] * inv, o1[4 * g + 2] * inv, o1[4 * g + 3] * inv});
    }
}

__device__ __forceinline__ void s5_lambar(const float* lam_re, const float* lam_im, float st, int idx, float& lr, float& li, float& br, float& bi) {
    lr = lam_re[idx]; li = lam_im[idx];
    const float er = __expf(lr * st); float s, c; sincos_acc(li * st, s, c); br = er * c; bi = er * s;
}
__device__ __forceinline__ void s5_unit(LAS unsigned char* lds, const Params& P, int l, int b, int g, const bf16_t* ub, bf16_t* y2) {
    const int tid = tid_opaque(), w = tid >> 6, lane = tid & 63, c15 = lane & 15, kq = lane >> 4;
    LAS float* BUs = (LAS float*)(lds + w * 14592);
    LAS unsigned char* Xs = lds + w * 14592 + 10240;
    LAS float* xe = (LAS float*)(lds + 8 * 14592);
    const float* lam_re = (const float*)PIN(13) + (l * 16 + g) * 64; const float* lam_im = (const float*)PIN(14) + (l * 16 + g) * 64;
    const float* b_re = (const float*)PIN(15) + (size_t)(l * 16 + g) * 64 * 16; const float* b_im = (const float*)PIN(16) + (size_t)(l * 16 + g) * 64 * 16;
    const float* c_re = (const float*)PIN(17) + (size_t)(l * 16 + g) * 16 * 64; const float* c_im = (const float*)PIN(18) + (size_t)(l * 16 + g) * 16 * 64;
    const f32x4 dh4 = *(const f32x4*)((const float*)PIN(19) + (l * 16 + g) * 16 + 4 * kq);
    const float st = __expf(((const float*)PIN(20))[l * 16 + g]);
    float lr_, li_, lbr, lbi; s5_lambar(lam_re, lam_im, st, lane, lr_, li_, lbr, lbi);
    bf16x8 bfr[8];
#pragma unroll
    for (int q = 0; q < 4; ++q) {
        const int pp = 16 * q + c15; float lr, li, br, bi; s5_lambar(lam_re, lam_im, st, pp, lr, li, br, bi);
        const float nr = br - 1.f, ni = bi, den = 1.f / (lr * lr + li * li);
        const float cfr = (nr * lr + ni * li) * den, cfi = (ni * lr - nr * li) * den;
        u32x4 wre = (u32x4){0, 0, 0, 0}, wim = wre;
        if (kq < 2) {
            float vr[8], vi[8];
#pragma unroll
            for (int j = 0; j < 8; ++j) { const float xr = b_re[pp * 16 + 8 * kq + j], xi = b_im[pp * 16 + 8 * kq + j]; vr[j] = cfr * xr - cfi * xi; vi[j] = cfr * xi + cfi * xr; }
#pragma unroll
            for (int j = 0; j < 4; ++j) { wre[j] = pk2(vr[2 * j], vr[2 * j + 1]); wim[j] = pk2(vi[2 * j], vi[2 * j + 1]); }
        }
        bfr[q] = __builtin_bit_cast(bf16x8, wre); bfr[q + 4] = __builtin_bit_cast(bf16x8, wim);
    }
    bf16x8 cfrg[4];
#pragma unroll
    for (int ks = 0; ks < 4; ++ks) { u32x4 wv;
#pragma unroll
        for (int j = 0; j < 4; ++j) { const int pp = 16 * ks + 4 * kq + j; wv[j] = pk2(c_re[c15 * 64 + pp], -c_im[c15 * 64 + pp]); }
        cfrg[ks] = __builtin_bit_cast(bf16x8, wv); }
    float Lr = lbr, Li = lbi;
#pragma unroll
    for (int i = 0; i < 8; ++i) { const float t = Lr * Lr - Li * Li; Li = 2.f * Lr * Li; Lr = t; }
    const long row0 = (long)b * SEQ + w * 256;
    float xr = 0.f, xi = 0.f;
    for (int pass = 0; pass < 2; ++pass) {
        u32x4 uw_n = (u32x4){0, 0, 0, 0};
        if (kq < 2) uw_n = *(const u32x4*)(ub + (row0 + c15) * 256 + g * 16 + 8 * kq);
        u32x2 uu_n = (u32x2){0u, 0u};
        if (pass) uu_n = *(const u32x2*)(ub + (row0 + c15) * 256 + g * 16 + 4 * kq);
#pragma unroll 1
        for (int sc = 0; sc < 16; ++sc) {
            const u32x4 uw = uw_n; const u32x2 uu_c = uu_n;
            if (sc < 15) {
                if (kq < 2) uw_n = *(const u32x4*)(ub + (row0 + 16 * (sc + 1) + c15) * 256 + g * 16 + 8 * kq);
                if (pass) uu_n = *(const u32x2*)(ub + (row0 + 16 * (sc + 1) + c15) * 256 + g * 16 + 4 * kq);
            }
            const bf16x8 uf = __builtin_bit_cast(bf16x8, uw);
#pragma unroll
            for (int nb = 0; nb < 8; ++nb) {
                const f32x4 d = __builtin_amdgcn_mfma_f32_16x16x32_bf16(uf, bfr[nb], (f32x4){0.f, 0.f, 0.f, 0.f}, 0, 0, 0);
                *(LAS f32x4*)(BUs + (16 * nb + c15) * 20 + 4 * kq) = d;
            }
            asm volatile("s_waitcnt lgkmcnt(0)" ::: "memory");
            f32x4 bre4[4], bim4[4];
#pragma unroll
            for (int q = 0; q < 4; ++q) { bre4[q] = *(const LAS f32x4*)(BUs + lane * 20 + 4 * q); bim4[q] = *(const LAS f32x4*)(BUs + (64 + lane) * 20 + 4 * q); }
#pragma unroll
            for (int tt = 0; tt < 16; ++tt) {
                const float bre = bre4[tt >> 2][tt & 3], bim = bim4[tt >> 2][tt & 3];
                const float nxr = lbr * xr - lbi * xi + bre, nxi = lbr * xi + lbi * xr + bim; xr = nxr; xi = nxi;
                if (pass) *(LAS unsigned*)(Xs + tt * 272 + lane * 4) = pk2(xr, xi);
            }
            asm volatile("s_waitcnt lgkmcnt(0)" ::: "memory");
            if (pass) {
                f32x4 ya = (f32x4){0.f, 0.f, 0.f, 0.f};
#pragma unroll
                for (int ks = 0; ks < 4; ++ks) { const bf16x8 a = *(const LAS bf16x8*)(Xs + c15 * 272 + (32 * ks + 8 * kq) * 2); ya = __builtin_amdgcn_mfma_f32_16x16x32_bf16(cfrg[ks], a, ya, 0, 0, 0); }
{ const long row = row0 + 16 * sc + c15; f32x4 o;
                  const f32x4 uu = (f32x4){__uint_as_float(uu_c.x << 16), __uint_as_float(uu_c.x & 0xffff0000u), __uint_as_float(uu_c.y << 16), __uint_as_float(uu_c.y & 0xffff0000u)};
#pragma unroll
                  for (int e = 0; e < 4; ++e) { const float y = ya[e] + dh4[e] * uu[e]; const float z = 0.7978845608028654f * (y + 0.044715f * y * y * y);
                      const float th = 1.f - 2.f * __builtin_amdgcn_rcpf(1.f + __builtin_amdgcn_exp2f(2.f * LOG2E * z)); o[e] = 0.5f * y * (1.f + th); }
                  store4(y2 + row * 256 + g * 16 + 4 * kq, o); }
                asm volatile("s_waitcnt lgkmcnt(0)" ::: "memory");
            }
        }
        if (pass == 0) {
            xe[(w * 64 + lane) * 2] = xr; xe[(w * 64 + lane) * 2 + 1] = xi;
            __syncthreads();
            float cr = 0.f, ci = 0.f;
            for (int w2 = 0; w2 < w; ++w2) { const float er = xe[(w2 * 64 + lane) * 2], ei = xe[(w2 * 64 + lane) * 2 + 1]; const float t = Lr * cr - Li * ci + er; ci = Lr * ci + Li * cr + ei; cr = t; }
            xr = cr; xi = ci;
        }
    }
    __syncthreads();
}

enum { CM_NAT = 0, CM_IN1, CM_IN2, CM_UQ, CM_UKV, CM_UP, CM_NATP };
__device__ __forceinline__ int perm32(int rho) { return 8 * ((rho & 15) >> 2) + 4 * (rho >> 4) + (rho & 3); }
__device__ __forceinline__ int colmap(int type, int n) {
    switch (type) {
    case CM_IN1: {
        if (n < 384) return (n & ~31) + perm32(n & 31);
        if (n < 416) return 640 + (n - 384);
        if (n < 420) return 1440 + (n - 416);
        if (n < 512) return -1;
        if (n < 768) { const int q = n - 512; return 384 + (q & ~31) + perm32(q & 31); }
        if (n < 1280) { const int t = (n - 768) / 256, p = (n - 768) % 256, bj = p / 128, wc = (p % 128) / 32, j = p % 32; return (t == 0 ? 672 : 928) + wc * 64 + 32 * bj + perm32(j); }
        if (n < 1536) { const int q = n - 1280; return 1184 + (q & ~31) + perm32(q & 31); }
        { const int q = n - 1536; return 1444 + (q & ~31) + perm32(q & 31); } }
    case CM_IN2: return 1700 + (n & ~31) + perm32(n & 31);
    case CM_UQ: { if (n < 256) { const int bj = n / 128, wc = (n % 128) / 32, j = n % 32; return wc * 96 + 32 * bj + perm32(j); } const int p = n - 256; if (p < 128) return (p / 32) * 96 + 64 + (p % 32); return -1; }
    case CM_UKV: { if (n < 256) { const int bj = n / 128, wc = (n % 128) / 32, j = n % 32; return wc * 128 + 32 * bj + perm32(j); } const int q0 = n - 256, q = (q0 & ~31) + perm32(q0 & 31); return (q / 64) * 128 + 64 + (q % 64); }
    case CM_UP: { const int pn = n / 256, q = n % 256, bj = q / 128, qq = q % 128; return bj * DFF + pn * 128 + (qq & ~31) + perm32(qq & 31); }
    case CM_NATP: return (n & ~31) + perm32(n & 31);
    default: return n;
    }
}
struct WEnt { const float* src; const float* gain; bf16_t* dst; int src_ld, K, Np, cm; };
__device__ __forceinline__ void wconv_item(LAS float* scr, const WEnt& e, int item, int lane) {
    const int nblk = e.Np / 32, kb = item / nblk, nb = item % nblk, k0 = 64 * kb, n0 = 32 * nb;
    const int col = colmap(e.cm, n0 + (lane & 31));
    const float* sp = e.src + (size_t)(k0 + (lane >> 5)) * e.src_ld + (col >= 0 ? col : 0);
    const float* gp = e.gain ? e.gain + k0 + (lane >> 5) : nullptr;
    float vv[32];
#pragma unroll
    for (int i = 0; i < 32; ++i) vv[i] = sp[(size_t)(2 * i) * e.src_ld];
#pragma unroll
    for (int i = 0; i < 32; ++i) { float v = vv[i]; if (gp) v *= gp[2 * i]; scr[(2 * i + (lane >> 5)) * 33 + (lane & 31)] = (col >= 0) ? v : 0.f; }
    asm volatile("s_waitcnt lgkmcnt(0)" ::: "memory");
    const int c = lane & 7;
#pragma unroll
    for (int j = 0; j < 4; ++j) { const int n = (lane >> 3) + 8 * j; const LAS float* sq = scr + (8 * c) * 33 + n;
        u32x4 o; o.x = pk2(sq[0 * 33], sq[1 * 33]); o.y = pk2(sq[2 * 33], sq[3 * 33]); o.z = pk2(sq[4 * 33], sq[5 * 33]); o.w = pk2(sq[6 * 33], sq[7 * 33]);
        *(u32x4*)(e.dst + (size_t)(n0 + n) * e.K + k0 + 8 * c) = o; }
    asm volatile("s_waitcnt lgkmcnt(0)" ::: "memory");
}
__device__ __forceinline__ void phase_weights(LAS unsigned char* lds, const Params& P, int l) {
    unsigned char* wsl = launder_ws(P.ws);
    bf16_t* W = (bf16_t*)(wsl + WS_W);
    const float* w_in = (const float*)PIN(3) + (size_t)l * DM * DIN;
    const float* an_g = (const float*)PIN(2) + l * DM;
    const int tid = tid_opaque(), w = tid >> 6, lane = tid & 63;
    LAS float* scr = (LAS float*)(lds + w * 8448);
    const int gw = blockIdx.x * 8 + w, NGW = gridDim.x * 8;
    constexpr int I0 = 16 * 56, I1 = 16 * 96, I2 = 6 * 16, I3 = 4 * 16, I4 = 4 * 8, I5 = 4 * 32, I8 = 16 * 32, I9 = 16 * 176, I10 = 44 * 32;
    constexpr int C0 = I0, C1 = C0 + I1, C2 = C1 + I2, C3 = C2 + I3, C4 = C3 + I4, C5 = C4 + I5, C6 = C5 + I5, C7 = C6 + I5, C8 = C7 + I8, C9 = C8 + I9, C10 = C9 + I10;
    for (int it = gw; it < C10; it += NGW) {
        WEnt e; int r;
        if (it < C0) { r = it; e = WEnt{w_in, an_g, W + WO_IN1 / 2, DIN, 1024, 1792, CM_IN1}; }
        else if (it < C1) { r = it - C0; e = WEnt{w_in, an_g, W + WO_IN2 / 2, DIN, 1024, 3072, CM_IN2}; }
        else if (it < C2) { r = it - C1; e = WEnt{(const float*)PIN(5) + (size_t)l * 384 * 384, (const float*)PIN(4) + l * 384, W + WO_UQ / 2, 384, 384, 512, CM_UQ}; }
        else if (it < C3) { r = it - C2; e = WEnt{(const float*)PIN(7) + (size_t)l * 256 * 512, (const float*)PIN(6) + l * 256, W + WO_UKV / 2, 512, 256, 512, CM_UKV}; }
        else if (it < C4) { r = it - C3; e = WEnt{(const float*)PIN(21) + (size_t)l * 256 * 256, nullptr, W + WO_GLU / 2, 256, 256, 256, CM_NATP}; }
        else if (it < C7) { const int z = (it - C4) / I5; r = (it - C4) % I5; e = WEnt{(const float*)PIN(23) + ((size_t)l * 3 + z) * 256 * 1024, nullptr, W + WO_B / 2 + (size_t)z * 1024 * 256, 1024, 256, 1024, CM_NATP}; }
        else if (it < C8) { r = it - C7; e = WEnt{(const float*)PIN(24) + (size_t)l * 1024 * 1024, nullptr, W + WO_OUT / 2, 1024, 1024, 1024, CM_NATP}; }
        else if (it < C9) { r = it - C8; e = WEnt{(const float*)PIN(26) + (size_t)l * 1024 * 5632, (const float*)PIN(25) + l * DM, W + WO_UP / 2, 5632, 1024, 5632, CM_UP}; }
        else { r = it - C9; e = WEnt{(const float*)PIN(28) + (size_t)l * DFF * 1024, nullptr, W + WO_DN / 2, 1024, DFF, 1024, CM_NATP}; }
        wconv_item(scr, e, r, lane);
    }
}
__device__ __forceinline__ void phase_prologue(const Params& P) {
    const float INVF[16] = {1.0f, 0.5623413324356079f, 0.3162277638912201f, 0.17782793939113617f, 0.10000000149011612f, 0.05623413249850273f, 0.03162277489900589f, 0.017782794311642647f,
                            0.009999999776482582f, 0.005623413249850273f, 0.003162277629598975f, 0.0017782794311642647f, 0.0010000000474974513f, 0.000562341301701963f, 0.0003162277571391314f, 0.00017782794020604342f};
    const int tid = tid_opaque(), w = tid >> 6, lane = tid & 63;
    const float* x = (const float*)PIN(0); const int* pos = (const int*)PIN(1);
    unsigned char* wsl = launder_ws(P.ws);
    bf16_t* xb = (bf16_t*)(wsl + WS_XB); float* sm = (float*)(wsl + WS_SM);
    float* ssqx = sm + SM_SSQX / 4; float* cosT = sm + SM_COS / 4; float* sinT = sm + SM_SIN / 4;
    float invf = 0.f;
#pragma unroll
    for (int i = 0; i < 16; ++i) if ((lane & 15) == i) invf = INVF[i];
    for (long row0 = ((long)blockIdx.x * 8 + w) * 4; row0 < MTOK; row0 += (long)gridDim.x * 32) {
        f32x4 v[4][4];
#pragma unroll
        for (int q = 0; q < 4; ++q)
#pragma unroll
            for (int j = 0; j < 4; ++j) v[q][j] = *(const f32x4*)(x + (row0 + q) * 1024 + j * 256 + lane * 4);
#pragma unroll
        for (int q = 0; q < 4; ++q) {
            const long row = row0 + q; float ss = 0.f;
#pragma unroll
            for (int j = 0; j < 4; ++j) { store4(xb + row * 1024 + j * 256 + lane * 4, v[q][j]); ss += dot4(v[q][j]); }
#pragma unroll
            for (int o = 1; o < 64; o <<= 1) ss += __shfl_xor(ss, o);
            if (lane < 16) { ssqx[row * 16 + lane] = (lane == 0) ? ss : 0.f;
                const float ang = (float)pos[row] * invf; float sn, cs; sincos_acc(ang, sn, cs); cosT[row * 16 + lane] = cs; sinT[row * 16 + lane] = sn; }
        }
    }
}

#define XB_TMO      128
#define XB_XCNT(j)  (256  + 64 * (j))
#define XB_XSUB(j)  (1280 + 64 * (j))
#define XB_XGEN(j)  (2304 + 64 * (j))
#define XB_TOP      3328
#define XB_TOPGEN   3392
#define XCD_BAR_WORDS 3456
#define XB_SPIN_CAP (1u << 18)
__device__ __forceinline__ unsigned xb_ld(unsigned* p)              { return __hip_atomic_load(p, __ATOMIC_RELAXED, __HIP_MEMORY_SCOPE_AGENT); }
__device__ __forceinline__ unsigned xb_add(unsigned* p, unsigned v) { return __hip_atomic_fetch_add(p, v, __ATOMIC_RELAXED, __HIP_MEMORY_SCOPE_AGENT); }
__device__ __forceinline__ unsigned xb_xcc_id() { return (unsigned)__builtin_amdgcn_s_getreg((3 << 11) | 20) & 0xFu; }
#define XB_SPIN(cond, bar) do { unsigned _sp = 0; while (cond) { __builtin_amdgcn_s_sleep(1); \
    if ((++_sp & 255u) == 0u) { if (xb_ld(&(bar)[XB_TMO])) break; if (_sp > XB_SPIN_CAP) { atomicAdd(&(bar)[XB_TMO], 1u); break; } } } } while (0)
struct XcdBarrier { unsigned* bar; unsigned x; volatile LAS unsigned* st; };
__device__ __forceinline__ XcdBarrier xcd_barrier_post(unsigned* bar, volatile LAS unsigned* st) {
    XcdBarrier b; b.bar = bar; b.x = xb_xcc_id(); b.st = st;
    if (tid_opaque() == 0) (void)xb_add(&bar[XB_XCNT(b.x)], 1u);
    return b;
}
__device__ __forceinline__ void xcd_barrier_complete(unsigned* bar, unsigned x, unsigned& nloc, unsigned& nx) {
    const unsigned G = gridDim.x * gridDim.y * gridDim.z;
    unsigned sum, cnt, mine, sp = 0u;
    for (;;) {
        sum = 0u; cnt = 0u; mine = 0u;
#pragma unroll
        for (unsigned j = 0; j < 16; ++j) { const unsigned c = xb_ld(&bar[XB_XCNT(j)]); sum += c; cnt += (c > 0u) ? 1u : 0u; mine = (j == x) ? c : mine; }
        if (sum == G) break;
        __builtin_amdgcn_s_sleep(1);
        if ((++sp & 255u) == 0u) { if (xb_ld(&bar[XB_TMO])) break; if (sp > XB_SPIN_CAP) { atomicAdd(&bar[XB_TMO], 1u); break; } }
    }
    nloc = mine > 0u ? mine : 1u; nx = cnt > 0u ? cnt : 1u;
}
__device__ __forceinline__ void xcd_barrier(const XcdBarrier& b) {
    asm volatile("s_waitcnt vmcnt(0)" ::: "memory");
    __syncthreads();
    if (tid_opaque() == 0) {
        unsigned* bar = b.bar;
        __builtin_amdgcn_s_waitcnt(0);
        unsigned nloc = b.st[0], nx = b.st[1];
        if (nloc == 0u) { xcd_barrier_complete(bar, b.x, nloc, nx); b.st[0] = nloc; b.st[1] = nx; }
        const unsigned old = xb_add(&bar[XB_XSUB(b.x)], 1u);
        const unsigned gen = old / nloc;
        if (old + 1u == (gen + 1u) * nloc) {
            __builtin_amdgcn_fence(__ATOMIC_RELEASE, "agent");
            asm volatile("s_waitcnt vmcnt(0)" ::: "memory");
            const unsigned og = xb_add(&bar[XB_TOP], 1u);
            const unsigned tg = og / nx;
            if (og + 1u == (tg + 1u) * nx) xb_add(&bar[XB_TOPGEN], 1u);
            else XB_SPIN(xb_ld(&bar[XB_TOPGEN]) == tg, bar);
            __builtin_amdgcn_fence(__ATOMIC_ACQUIRE, "agent");
            xb_add(&bar[XB_XGEN(b.x)], 1u);
            asm volatile("s_waitcnt vmcnt(0)" ::: "memory");
        } else {
            XB_SPIN(xb_ld(&bar[XB_XGEN(b.x)]) == gen, bar);
            __builtin_amdgcn_fence(__ATOMIC_ACQUIRE, "agent");
            asm volatile("s_waitcnt vmcnt(0)" ::: "memory");
        }
    }
    __syncthreads();
}

__global__ void __launch_bounds__(512, 2) mega(Params P, int ph_lo, int ph_hi) {
    extern __shared__ __attribute__((aligned(16))) unsigned char lds_raw[];
    LAS unsigned char* lds = (LAS unsigned char*)lds_raw;
    cg::grid_group grid = cg::this_grid();
    volatile LAS unsigned* bst = (volatile LAS unsigned*)(lds + LDS_XOFF + 8192);
    { const int t4 = tid_opaque(); if (t4 < 4) bst[t4] = 0u; }
    __syncthreads();
    XcdBarrier bar; bar.bar = (unsigned*)P.ws; bar.x = 0; bar.st = bst;
    if (ph_hi - ph_lo > 1) bar = xcd_barrier_post((unsigned*)P.ws, bst);
    for (int ph = ph_lo; ph < ph_hi; ++ph) {
    int G = gridDim.x, c = blockIdx.x; asm volatile("" : "+s"(G), "+s"(c));
    unsigned char* ws = launder_ws(P.ws);
    float* outp = (float*)launder_ws((unsigned char*)P.out);
    bf16_t* W = (bf16_t*)(ws + WS_W);
    bf16_t* xb = (bf16_t*)(ws + WS_XB);
    float* sm = (float*)(ws + WS_SM);
    float *ssqx = sm + SM_SSQX / 4, *ssq_cq = sm + SM_SSQCQ / 4, *ssq_ckv = sm + SM_SSQCKV / 4, *kr_rot = sm + SM_KRROT / 4, *ssq_kr = sm + SM_SSQKR / 4, *logf_ = sm + SM_LOGF / 4,
          *cl = sm + SM_CL / 4, *ssq_qn = sm + SM_SSQQN / 4, *ssq_qr = sm + SM_SSQQR / 4, *cosT = sm + SM_COS / 4, *sinT = sm + SM_SIN / 4;
    bf16_t* obr = (bf16_t*)(ws + WS_OBR);
    unsigned char* X = ws + WS_X;
    bf16_t *cq = (bf16_t*)(X + XA_CQ), *ckv = (bf16_t*)(X + XA_CKV), *ub = (bf16_t*)(X + XA_U), *qf = (bf16_t*)(X + XA_QF), *kf = (bf16_t*)(X + XA_KF), *vf = (bf16_t*)(X + XA_VF),
           *y2 = (bf16_t*)(X + XA_Y2), *qm = (bf16_t*)(X + XA_QM), *km = (bf16_t*)(X + XA_KM), *vm = (bf16_t*)(X + XA_VM);
    bf16_t *gates = (bf16_t*)(X + XB_GATES), *merged = (bf16_t*)(X + XB_MERGED), *act = (bf16_t*)(X + XC_ACT);
        const int l = ph / NPHASE_PER_LAYER, k = ph % NPHASE_PER_LAYER;
        {
        if (k == 0 && PHON(0)) {
            phase_weights(lds, P, l);
            if (l == 0) phase_prologue(P);
        } else if (k == 1 && PHON(1)) {
            pg8::Gemm g{xb, W + WO_IN1 / 2, 1024, 1024, 1024, 0, 0, 0}; pg8::Sched S; S.init(MTOK / 256, 7, G, c, 1, 0);
            EpiIn1 E{ssqx, cq, ckv, qf, kf, vf, ub, ssq_cq, ssq_ckv, ssq_kr, kr_rot, logf_, cosT, sinT, (const float*)PIN(9) + l * 96, (const float*)PIN(10) + l * 64, (const float*)PIN(11) + l * 64, (const float*)PIN(12) + l * 4};
            pg8::gemm_phase(lds, g, S, E);
        } else if (k == 2 && PHON(2)) {
            for (int q = c; q < 256; q += G) s5_unit(lds, P, l, q >> 4, q & 15, ub, y2);
        } else if (k == 3 && PHON(3)) {
            { pg8::Gemm g{cq, W + WO_UQ / 2, 384, 384, 384, 0, 0, 0}; pg8::Sched S; S.init(MTOK / 256, 2, G, c, 1, 0);
              EpiUq E{ssq_cq, qm, ssq_qn, ssq_qr, cosT, sinT, (const float*)PIN(8) + l * 96}; pg8::gemm_phase(lds, g, S, E); }
            { pg8::Gemm g{ckv, W + WO_UKV / 2, 256, 256, 256, 0, 0, 0}; pg8::Sched S; S.init(MTOK / 256, 2, G, c, 1, 0);
              EpiUkv E{ssq_ckv, ssq_kr, kr_rot, (const float*)PIN(9) + l * 96, km, vm}; pg8::gemm_phase(lds, g, S, E); }
            { pg8::Gemm g{y2, W + WO_GLU / 2, 256, 256, 256, 0, 0, 0}; pg8::Sched S; S.init(MTOK / 256, 1, G, c, 1, 0);
              EpiGlu E{y2, (const float*)PIN(22) + l * 256, obr + (size_t)2 * MTOK * 256}; pg8::gemm_phase(lds, g, S, E); }
            { const int cs = (G >= 192) ? (c >= 128 ? c - 128 : c + (G - 128)) : c;
            for (int q = cs; q < 64; q += G) {
                if (tid_opaque() < 64) { const int lane = tid_opaque() & 63, b = q >> 2, h = q & 3; const long base = ((long)b * SEQ + 32 * lane) * 4 + h;
                    float tot = 0.f;
                    for (int i = 0; i < 32; ++i) tot += logf_[base + 4 * i];
                    float inc = tot;
#pragma unroll
                    for (int o = 1; o < 64; o <<= 1) { const float t = __shfl_up(inc, o); if (lane >= o) inc += t; }
                    float run = inc - tot;
                    for (int i = 0; i < 32; ++i) { run += logf_[base + 4 * i]; cl[base + 4 * i] = run * LOG2E; } }
            }
            }
        } else if (k == 4 && PHON(4)) {
            for (int idx = c; idx < 256; idx += G) {
                const int b = idx >> 4, h = (idx >> 2) & 3, pr = idx & 3;
                attn_unit<true>(lds, qm, km, vm, obr, ssq_qn, ssq_qr, cl, b, h, 7 - pr);
                attn_unit<false>(lds, qf, kf, vf, obr + (size_t)MTOK * 256, ssq_qn, ssq_qr, cl, b, h, 7 - pr);
                attn_unit<true>(lds, qm, km, vm, obr, ssq_qn, ssq_qr, cl, b, h, pr);
                attn_unit<false>(lds, qf, kf, vf, obr + (size_t)MTOK * 256, ssq_qn, ssq_qr, cl, b, h, pr);
            }
        } else if (k == 5 && PHON(5)) {
            pg8::Gemm g{xb, W + WO_IN2 / 2, 1024, 1024, 1024, 0, 0, PROBE_KREP == 5 ? 2 : 0}; pg8::Sched S; S.init(MTOK / 256, 12, G, c, 1, 0);
            EpiGates E{ssqx, gates}; pg8::gemm_phase(lds, g, S, E);
        } else if (k == 6 && PHON(6)) {
            pg8::Gemm g{obr, W + WO_B / 2, 256, 256, 256, (long)MTOK * 256, 1024L * 256, 0}; pg8::Sched S; S.init(MTOK / 256, 4, G, c, 3, 0);
            EpiWb E{gates, merged}; pg8::gemm_phase(lds, g, S, E);
        } else if (k == 7 && PHON(7)) {
            pg8::Gemm g{merged, W + WO_OUT / 2, 1024, 1024, 1024, 0, 0, 0}; pg8::Sched S; S.init(MTOK / 256, 4, G, c, 1, 0);
            EpiRes E{l == 0 ? (const float*)PIN(0) : (const float*)nullptr, nullptr, xb, ssqx}; pg8::gemm_phase(lds, g, S, E);
        } else if (k == 8 && PHON(8)) {
            pg8::Gemm g{xb, W + WO_UP / 2, 1024, 1024, 1024, 0, 0, PROBE_KREP == 8 ? 2 : 0}; pg8::Sched S; S.init(NB * 8 + 2, 22, G, c, 1, 1);
            EpiUp E{ssqx, (const float*)PIN(27) + (size_t)l * 3 * 5632, act}; pg8::gemm_phase(lds, g, S, E);
        } else if (PHON(9)) {
            pg8::Gemm g{act, W + WO_DN / 2, DFF, DFF, DFF, 0, 0, 0}; pg8::Sched S; S.init(MTOK / 256, 4, G, c, 1, 0);
            EpiRes E{nullptr, l == NLAYER - 1 ? outp : (float*)nullptr, xb, ssqx}; pg8::gemm_phase(lds, g, S, E);
        }
        }
        if (ph + 1 < ph_hi) { if (ph_lo < 0) grid.sync(); else xcd_barrier(bar); }
    }
}

extern "C" void kernel_launch(void* const* d_in, const int* in_sizes, int n_in, void* d_out, int out_size, void* d_ws, size_t ws_size, hipStream_t stream) {
    static int grid = 0;
    if (grid == 0) {
        if (n_in != 29 || in_sizes[0] != MTOK * DM || out_size != MTOK * DM || ws_size < WS_END) {
            fprintf(stderr, "kernel_launch: unexpected shapes / workspace (n_in %d, in0 %d, out %d, ws %zu, need %zu)\n", n_in, n_in > 0 ? in_sizes[0] : -1, out_size, ws_size, (size_t)WS_END); grid = -1; return; }
        int dev = 0, cus = 0, per_cu = 0;
        hipGetDevice(&dev); hipDeviceGetAttribute(&cus, hipDeviceAttributeMultiprocessorCount, dev);
        hipFuncSetAttribute((const void*)mega, hipFuncAttributeMaxDynamicSharedMemorySize, LDS_BYTES);
        hipOccupancyMaxActiveBlocksPerMultiprocessor(&per_cu, (const void*)mega, 512, LDS_BYTES);
        if (per_cu < 1) { fprintf(stderr, "kernel_launch: occupancy query says %d blocks per CU\n", per_cu); per_cu = 1; }
        (void)hipGetLastError();
        grid = cus * 1;
    }
    if (grid < 0) return;
    Params p{};
    for (int i = 0; i < 29; ++i) p.in[i] = d_in[i];
    p.out = (float*)d_out; p.ws = (unsigned char*)d_ws;
    if (hipMemsetAsync(d_ws, 0, 16384, stream) != hipSuccess) { fprintf(stderr, "memset failed\n"); return; }
#if MK_MULTI
    for (int ph = 0; ph < NPHASE; ++ph) hipLaunchKernelGGL(mega, dim3(grid), dim3(512), LDS_BYTES, stream, p, ph, ph + 1);
#else
    int lo = 0, hi = NPHASE;
    void* args[] = {&p, &lo, &hi};
    hipError_t e = hipLaunchCooperativeKernel((const void*)mega, dim3(grid), dim3(512), args, LDS_BYTES, stream);
    if (e != hipSuccess) fprintf(stderr, "cooperative launch failed: %s (grid %d)\n", hipGetErrorString(e), grid);
#endif
}
```
